# Optimizing an MI355X kernel written in HIP

```python
import jax, jax.numpy as jnp
from jax import lax
import numpy as np

D_MODEL = 1024
BATCH = 8
SEQ = 2048
DEPTH = 1
DEC_BATCH = 128
DEC_SEQ = 4
PAST_LEN = 16384
PAGE_SIZE = 128

N_META = 16
MIX_WIDTH = D_MODEL
C_CONV = MIX_WIDTH // 2
C_POOL = MIX_WIDTH - C_CONV
CONV_HEADS = 8
CONV_WIDTH = 31
CONV_HIST = CONV_WIDTH - 1
POOL_WINDOWS = (2, 4, 8, 16)
N_POOL_GROUPS = len(POOL_WINDOWS)
POOL_GROUP = C_POOL // N_POOL_GROUPS
POOL_HIST = max(POOL_WINDOWS) - 1
D_IN = 2 * C_CONV + C_POOL
D_FF = ((8 * D_MODEL // 3 + 127) // 128) * 128
EPS = 1e-6

kernel_name = "hymba_conv_pool_macaron_step"


def rmsnorm(x, g):
    xf = x.astype(jnp.float32)
    y = xf * lax.rsqrt(jnp.mean(xf * xf, axis=-1, keepdims=True) + EPS)
    return (y * g.astype(jnp.float32)).astype(x.dtype)


def layernorm(x, g, b):
    xf = x.astype(jnp.float32)
    mu = jnp.mean(xf, axis=-1, keepdims=True)
    xc = xf - mu
    var = jnp.mean(xc * xc, axis=-1, keepdims=True)
    y = xc * lax.rsqrt(var + EPS) * g.astype(jnp.float32) + b.astype(jnp.float32)
    return y.astype(x.dtype)


def swiglu(x, wg, wu, wd):
    return (jax.nn.silu(x @ wg) * (x @ wu)) @ wd


def depthwise_causal_conv(u_ext, w, b):
    out = lax.conv_general_dilated(
        u_ext, w.astype(u_ext.dtype)[:, None, :], window_strides=(1,), padding="VALID",
        dimension_numbers=("NWC", "WIO", "NWC"), feature_group_count=u_ext.shape[-1])
    return out + b.astype(u_ext.dtype)


def multiscale_pool(p_ext, pos0, w_lin, scale):
    bsz, L, _ = p_ext.shape
    T = L - POOL_HIST
    pf = p_ext.astype(jnp.float32)
    cs = jnp.concatenate([jnp.zeros_like(pf[:, :1]), jnp.cumsum(pf, axis=1)], axis=1)
    end = cs[:, POOL_HIST + 1:]
    pos = pos0 + jnp.arange(T)
    means = []
    for g, w in enumerate(POOL_WINDOWS):
        sl = slice(g * POOL_GROUP, (g + 1) * POOL_GROUP)
        start = cs[:, POOL_HIST + 1 - w: POOL_HIST + 1 - w + T, sl]
        cnt = jnp.minimum(pos + 1, w).astype(jnp.float32)[None, :, None]
        means.append((end[..., sl] - start) / cnt)
    d = jnp.concatenate(means, axis=-1) - pf[:, POOL_HIST:]
    d = d.reshape(bsz, T, N_POOL_GROUPS, POOL_GROUP)
    y = jnp.einsum("btgc,gcd->btgd", d, w_lin.astype(jnp.float32)).reshape(bsz, T, C_POOL)
    return (y * scale.astype(jnp.float32)).astype(p_ext.dtype)


def hybrid_layer(x, conv_prev, pool_prev, pos0,
                 g1, w1g, w1u, w1d, gm, w_in, b_in, w_dw, b_dw, ln_g, ln_b,
                 w_pool, pool_scale, w_out, b_out, g2, w2g, w2u, w2d):
    x = x + 0.5 * swiglu(rmsnorm(x, g1), w1g, w1u, w1d)
    h = rmsnorm(x, gm)
    z = h @ w_in + b_in
    u = z[..., :C_CONV] * jax.nn.sigmoid(z[..., C_CONV:2 * C_CONV])
    p_in = z[..., 2 * C_CONV:]
    u_ext = jnp.concatenate([conv_prev.astype(u.dtype), u], axis=1)
    c = depthwise_causal_conv(u_ext, w_dw, b_dw)
    c = jax.nn.silu(layernorm(c, ln_g, ln_b))
    p_ext = jnp.concatenate([pool_prev.astype(p_in.dtype), p_in], axis=1)
    q = multiscale_pool(p_ext, pos0, w_pool, pool_scale)
    x = x + jnp.concatenate([c, q], axis=-1) @ w_out + b_out
    x = x + 0.5 * swiglu(rmsnorm(x, g2), w2g, w2u, w2d)
    return x, u_ext[:, -CONV_HIST:], p_ext[:, -POOL_HIST:]


def setup_inputs(seed: int = 0) -> dict:
    key = jax.random.key(seed)
    ks = jax.random.split(key, 24)
    n = jax.random.normal
    f = jnp.float32

    def gain(k, shape):
        return 1.0 + 0.05 * n(k, shape, f)

    return {
        "x_prompt": n(ks[0], (BATCH, SEQ, D_MODEL), f),
        "x_sample": n(ks[1], (DEC_BATCH, DEC_SEQ, D_MODEL), f),
        "state_conv": 0.5 * n(ks[2], (DEPTH, DEC_BATCH, CONV_HIST, C_CONV), f),
        "state_pool": n(ks[3], (DEPTH, DEC_BATCH, POOL_HIST, C_POOL), f),
        "meta_tokens": n(ks[4], (N_META, D_MODEL), f),
        "norm_ffn1": gain(ks[5], (DEPTH, D_MODEL)),
        "w_ffn1_gate": n(ks[6], (DEPTH, D_MODEL, D_FF), f) * D_MODEL ** -0.5,
        "w_ffn1_up": n(ks[7], (DEPTH, D_MODEL, D_FF), f) * D_MODEL ** -0.5,
        "w_ffn1_down": n(ks[8], (DEPTH, D_FF, D_MODEL), f) * D_FF ** -0.5,
        "norm_mix": gain(ks[9], (DEPTH, D_MODEL)),
        "w_in": n(ks[10], (DEPTH, D_MODEL, D_IN), f) * D_MODEL ** -0.5,
        "b_in": 0.02 * n(ks[11], (DEPTH, D_IN), f),
        "w_dw": n(ks[12], (DEPTH, CONV_WIDTH, C_CONV), f) * CONV_WIDTH ** -0.5,
        "b_dw": 0.02 * n(ks[13], (DEPTH, C_CONV), f),
        "ln_conv_g": gain(ks[14], (DEPTH, C_CONV)),
        "ln_conv_b": 0.02 * n(ks[15], (DEPTH, C_CONV), f),
        "w_pool": n(ks[16], (DEPTH, N_POOL_GROUPS, POOL_GROUP, POOL_GROUP), f) * POOL_GROUP ** -0.5,
        "pool_scale": gain(ks[17], (DEPTH, C_POOL)),
        "w_out": n(ks[18], (DEPTH, MIX_WIDTH, D_MODEL), f) * MIX_WIDTH ** -0.5,
        "b_out": 0.02 * n(ks[19], (DEPTH, D_MODEL), f),
        "norm_ffn2": gain(ks[20], (DEPTH, D_MODEL)),
        "w_ffn2_gate": n(ks[21], (DEPTH, D_MODEL, D_FF), f) * D_MODEL ** -0.5,
        "w_ffn2_up": n(ks[22], (DEPTH, D_MODEL, D_FF), f) * D_MODEL ** -0.5,
        "w_ffn2_down": n(ks[23], (DEPTH, D_FF, D_MODEL), f) * D_FF ** -0.5,
        "norm_final": gain(jax.random.fold_in(key, 99), (D_MODEL,)),
    }


def reference(x_prompt, x_sample, state_conv, state_pool, meta_tokens,
              norm_ffn1, w_ffn1_gate, w_ffn1_up, w_ffn1_down,
              norm_mix, w_in, b_in, w_dw, b_dw, ln_conv_g, ln_conv_b,
              w_pool, pool_scale, w_out, b_out,
              norm_ffn2, w_ffn2_gate, w_ffn2_up, w_ffn2_down, norm_final):
    bsz = x_prompt.shape[0]
    meta = jnp.broadcast_to(meta_tokens.astype(x_prompt.dtype)[None], (bsz, N_META, D_MODEL))
    xp = jnp.concatenate([meta, x_prompt], axis=1)
    xs = x_sample
    conv_p, pool_p, conv_s, pool_s = [], [], [], []
    for l in range(DEPTH):
        params = (norm_ffn1[l], w_ffn1_gate[l], w_ffn1_up[l], w_ffn1_down[l],
                  norm_mix[l], w_in[l], b_in[l], w_dw[l], b_dw[l], ln_conv_g[l], ln_conv_b[l],
                  w_pool[l], pool_scale[l], w_out[l], b_out[l],
                  norm_ffn2[l], w_ffn2_gate[l], w_ffn2_up[l], w_ffn2_down[l])
        zc = jnp.zeros((bsz, CONV_HIST, C_CONV), xp.dtype)
        zp = jnp.zeros((bsz, POOL_HIST, C_POOL), xp.dtype)
        xp, cpn, ppn = hybrid_layer(xp, zc, zp, 0, *params)
        xs, csn, psn = hybrid_layer(xs, state_conv[l], state_pool[l], PAST_LEN, *params)
        conv_p.append(cpn)
        pool_p.append(ppn)
        conv_s.append(csn)
        pool_s.append(psn)
    y_prompt = rmsnorm(xp, norm_final)[:, N_META:]
    y_sample = rmsnorm(xs, norm_final)
    new_conv_prompt = jnp.stack(conv_p, axis=0)
    new_pool_prompt = jnp.stack(pool_p, axis=0)
    new_conv_sample = jnp.stack(conv_s, axis=0)
    new_pool_sample = jnp.stack(pool_s, axis=0)
    return (y_prompt, y_sample, new_conv_prompt, new_pool_prompt, new_conv_sample, new_pool_sample)
```

```cpp
#include <hip/hip_runtime.h>
#include <hip/hip_cooperative_groups.h>
#include <cstdio>
#include <cstdint>
namespace cg = cooperative_groups;

#ifndef MK_N_LAUNCHES
#define MK_N_LAUNCHES 9
#endif

#define LAS __attribute__((address_space(3)))
typedef unsigned short bf16_t;
typedef short bf16x8 __attribute__((ext_vector_type(8)));
typedef float f32x4 __attribute__((ext_vector_type(4)));
typedef unsigned u32x4 __attribute__((ext_vector_type(4)));
typedef unsigned u32x2 __attribute__((ext_vector_type(2)));

constexpr int D = 1024, FF = 2816, NB = 8, NMETA = 16, SEQ = 2048, TP = NMETA + SEQ  , MPR = NB * TP  ;
constexpr int NSB = 128, TS = 4, MSA = NSB * TS  , M = MPR + MSA  , MP = 17152  ;
constexpr int CC = 512, CPL = 512, DIN = 1536, CW = 31, CH = 30, PH = 15, PG = 128;
constexpr float EPS = 1e-6f;
constexpr int PAST_LEN = 16384;

constexpr size_t MiB = 1u << 20;
constexpr size_t WS_CTL = 0, CTL_ZERO_BYTES = 64 * 1024;
constexpr size_t WS_SSQ1 = 1 * MiB, WS_SSQ2 = 1 * MiB + 1280 * 1024, WS_SSQ3 = 1 * MiB + 2560 * 1024;
constexpr size_t WS_W1C = 6 * MiB, WS_W1D = 17 * MiB, WS_WIN = 22 * MiB + 512 * 1024, WS_WOUT = 25 * MiB + 512 * 1024, WS_W2C = 27 * MiB + 512 * 1024, WS_W2D = 38 * MiB + 512 * 1024;
constexpr size_t WS_XB = 44 * MiB;
constexpr size_t WS_X = 78 * MiB;
constexpr size_t WS_R1 = 145 * MiB;
constexpr size_t WS_UP = WS_R1, WS_A4 = WS_R1 + 34 * MiB;
constexpr size_t WS_END = WS_R1 + (size_t)MP * FF * 2;
static_assert(WS_END <= 256 * MiB, "ws map");
static_assert(WS_SSQ3 + (size_t)MP * 64 <= WS_W1C && WS_XB + (size_t)MP * D * 2 <= WS_X && WS_X + (size_t)MP * D * 4 <= WS_R1 && WS_A4 + (size_t)MP * D * 2 <= WS_END, "ws map 2");

namespace pg8 {
constexpr int BM = 256, BK = 64, HALF = 128, HTB = HALF * BK * 2, STAGE_BYTES = 8 * HTB, NXCD = 8, WGM = 8;
__host__ __device__ __forceinline__ int lds_byte(int r, int c) { const int st = (r >> 4) * 2 + (c >> 5), rr = r & 15, cc = c & 31, ob = rr * 64 + cc * 2; return st * 1024 + (ob ^ (((ob >> 9) & 1) << 5)); }
__host__ __device__ __forceinline__ void stage_rc(int b, int& R, int& C) { const int st = b / 1024, sb = b % 1024, swz = sb ^ (((sb >> 9) & 1) << 5); R = (st >> 1) * 16 + swz / 64; C = (st & 1) * 32 + (swz % 64) / 2; }
__host__ __device__ __forceinline__ int perm32(int rho) { const int n = rho >> 4, i = rho & 15; return 8 * (i >> 2) + 4 * n + (i & 3); }

struct Unit { int pm, pn; };
struct Gemm { const bf16_t* A; const bf16_t* Bt; int M, N, K; };

struct StaticOrder {
    int nM, nN, nwg, G, c;
    __device__ void init(int M_, int N_, int G_, int c_) { nM = M_ / BM; nN = N_ / BM; nwg = nM * nN; G = G_; c = c_; }
    __device__ bool next(int i, Unit& u) const {
        const long L = (long)i * G + c; if (L >= nwg) return false;
        int wgid = (int)L; { const int q = nwg / NXCD, r = nwg % NXCD, xcd = wgid % NXCD, off = wgid / NXCD; wgid = (xcd < r ? xcd * (q + 1) : r * (q + 1) + (xcd - r) * q) + off; }
        const int nig = WGM * nN, gid = wgid / nig, fm = gid * WGM, gsz = (nM - fm) < WGM ? (nM - fm) : WGM;
        u.pm = fm + ((wgid % nig) % gsz); u.pn = (wgid % nig) / gsz; return true;
    }
    __device__ __forceinline__ void a_ready(const Unit&) const {}
    __device__ __forceinline__ void done(const Unit&) const {}
};

__device__ __forceinline__ unsigned cvt_pk_bf16(float lo, float hi) { unsigned r; asm volatile("v_cvt_pk_bf16_f32 %0, %1, %2" : "=v"(r) : "v"(lo), "v"(hi)); return r; }
__device__ __forceinline__ float sigmoidf_(float x) { return __builtin_amdgcn_rcpf(1.0f + __builtin_amdgcn_exp2f(-1.44269504089f * x)); }

__device__ __forceinline__ float row_rs(const float* ssq, int row, int fq) {
    const f32x4 p = *(const f32x4*)(ssq + (size_t)row * 16 + 4 * fq);
    float s = (p.x + p.y) + (p.z + p.w);
    s += __shfl_xor(s, 16); s += __shfl_xor(s, 32);
    return __builtin_amdgcn_rsqf(s * (1.0f / D) + EPS);
}


template <bool SCALE> struct EpiSwiglu {
    static constexpr bool PERM = true, AFTER_DRAIN = false;
    bf16_t* O; const float* ssq;
    __device__ __forceinline__ void operator()(const f32x4 (&acc)[2][2][4][2], const Unit& u, int wr, int wc, int fr, int fq) const {
        const int row0 = u.pm * BM + wr * 64 + fr, col0 = u.pn * HALF + wc * 32 + 8 * fq;
#pragma unroll
        for (int ai = 0; ai < 2; ++ai)
#pragma unroll
            for (int m = 0; m < 4; ++m) {
                const int row = row0 + ai * HALF + m * 16;
                float r = 1.0f; if (SCALE) r = row_rs(ssq, row, fq);
                unsigned w[4];
#pragma unroll
                for (int n = 0; n < 2; ++n) {
                    f32x4 g = acc[ai][0][m][n], up = acc[ai][1][m][n];
                    if (SCALE) { g = g * r; up = up * r; }
                    float v[4];
#pragma unroll
                    for (int j = 0; j < 4; ++j) v[j] = g[j] * sigmoidf_(g[j]) * up[j];
                    w[2 * n] = cvt_pk_bf16(v[0], v[1]); w[2 * n + 1] = cvt_pk_bf16(v[2], v[3]);
                }
                *(u32x4*)(O + (size_t)row * FF + col0) = (u32x4){w[0], w[1], w[2], w[3]};
            }
    }
};

template <bool BIAS, bool WRITE_XB> struct EpiResid {
    static constexpr bool PERM = false, AFTER_DRAIN = false;
    float* X; bf16_t* XB; float* ssq; const float* bias; float alpha;
    __device__ __forceinline__ void operator()(const f32x4 (&acc)[2][2][4][2], const Unit& u, int wr, int wc, int fr, int fq) const {
        const int row0 = u.pm * BM + wr * 64 + fr, col0 = u.pn * BM + wc * 32 + 4 * fq;
        f32x4 bv[2][2];
#pragma unroll
        for (int bj = 0; bj < 2; ++bj)
#pragma unroll
            for (int n = 0; n < 2; ++n) bv[bj][n] = BIAS ? *(const f32x4*)(bias + col0 + bj * HALF + n * 16) : (f32x4){0.f, 0.f, 0.f, 0.f};
#pragma unroll
        for (int ai = 0; ai < 2; ++ai)
#pragma unroll
            for (int m = 0; m < 4; ++m) {
                const int row = row0 + ai * HALF + m * 16; const size_t off = (size_t)row * D + col0; float s = 0.f;
#pragma unroll
                for (int bj = 0; bj < 2; ++bj)
#pragma unroll
                    for (int n = 0; n < 2; ++n) {
                        f32x4 x = *(const f32x4*)(X + off + bj * HALF + n * 16);
                        x = x + acc[ai][bj][m][n] * alpha + bv[bj][n];
                        *(f32x4*)(X + off + bj * HALF + n * 16) = x;
                        s += (x[0] * x[0] + x[1] * x[1]) + (x[2] * x[2] + x[3] * x[3]);
                        if (WRITE_XB) *(u32x2*)(XB + off + bj * HALF + n * 16) = (u32x2){cvt_pk_bf16(x[0], x[1]), cvt_pk_bf16(x[2], x[3])};
                    }
                s += __shfl_xor(s, 16); s += __shfl_xor(s, 32);
                if (fq == 0) ssq[(size_t)row * 16 + u.pn * 4 + wc] = s;
                asm volatile("" ::: "memory");
            }
    }
};

struct EpiWin {
    static constexpr bool PERM = true, AFTER_DRAIN = false;
    bf16_t* UP; const float* ssq; const float* bin;
    __device__ __forceinline__ void operator()(const f32x4 (&acc)[2][2][4][2], const Unit& u, int wr, int wc, int fr, int fq) const {
        const int row0 = u.pm * BM + wr * 64 + fr, cc0 = wc * 32 + 8 * fq;
        if (u.pn < 4) {
            f32x4 ba[2], bg[2];
#pragma unroll
            for (int n = 0; n < 2; ++n) { ba[n] = *(const f32x4*)(bin + u.pn * HALF + cc0 + 4 * n); bg[n] = *(const f32x4*)(bin + CC + u.pn * HALF + cc0 + 4 * n); }
#pragma unroll
            for (int ai = 0; ai < 2; ++ai)
#pragma unroll
                for (int m = 0; m < 4; ++m) {
                    const int row = row0 + ai * HALF + m * 16; const float r = row_rs(ssq, row, fq);
                    unsigned w[4];
#pragma unroll
                    for (int n = 0; n < 2; ++n) {
                        const f32x4 a = acc[ai][0][m][n] * r + ba[n], g = acc[ai][1][m][n] * r + bg[n];
                        float v[4];
#pragma unroll
                        for (int j = 0; j < 4; ++j) v[j] = a[j] * sigmoidf_(g[j]);
                        w[2 * n] = cvt_pk_bf16(v[0], v[1]); w[2 * n + 1] = cvt_pk_bf16(v[2], v[3]);
                    }
                    *(u32x4*)(UP + (size_t)row * 1024 + u.pn * HALF + cc0) = (u32x4){w[0], w[1], w[2], w[3]};
                }
        } else {
            const int zc0 = 1024 + (u.pn - 4) * BM + cc0, oc0 = CC + (u.pn - 4) * BM + cc0;
            f32x4 bz[2][2];
#pragma unroll
            for (int bj = 0; bj < 2; ++bj)
#pragma unroll
                for (int n = 0; n < 2; ++n) bz[bj][n] = *(const f32x4*)(bin + zc0 + bj * HALF + 4 * n);
#pragma unroll
            for (int ai = 0; ai < 2; ++ai)
#pragma unroll
                for (int m = 0; m < 4; ++m) {
                    const int row = row0 + ai * HALF + m * 16; const float r = row_rs(ssq, row, fq);
#pragma unroll
                    for (int bj = 0; bj < 2; ++bj) {
                        const f32x4 v0 = acc[ai][bj][m][0] * r + bz[bj][0], v1 = acc[ai][bj][m][1] * r + bz[bj][1];
                        *(u32x4*)(UP + (size_t)row * 1024 + oc0 + bj * HALF) = (u32x4){cvt_pk_bf16(v0[0], v0[1]), cvt_pk_bf16(v0[2], v0[3]), cvt_pk_bf16(v1[0], v1[1]), cvt_pk_bf16(v1[2], v1[3])};
                    }
                }
        }
    }
};

template <class Epi, class Sched, bool ALIGN_EPI = false, bool SP2 = false>
__device__ __forceinline__ void gemm_phase(LAS unsigned char* lds, const Gemm g, const Sched& S, const Epi& E) {
    const int tid = threadIdx.x, wid = __builtin_amdgcn_readfirstlane(tid >> 6), lane = tid & 63, wr = wid >> 2, wc = wid & 3, fr = lane & 15, fq = lane >> 4;
    const int K = g.K, nt = K / BK;
    unsigned voffA[2], voffB[2];
#pragma unroll
    for (int i = 0; i < 2; ++i) { int R, C; stage_rc(tid * 16 + i * 8192, R, C); const int Rb = Epi::PERM ? ((R & ~31) + perm32(R & 31)) : R;
        voffA[i] = (unsigned)(R * K + C) * 2u; voffB[i] = (unsigned)(Rb * K + C) * 2u; }
    const size_t kstep = (size_t)(BK * 2);
    const size_t hstep = (size_t)HALF * K * 2;
    const size_t tstep = 2 * hstep;
    const unsigned ldsw = (unsigned)wid * 1024u;
    const int aoff = lds_byte(wr * 64 + fr, fq * 8), boff = lds_byte(wc * 32 + fr, fq * 8);
#define PG8_SA(b, h) (((b) * 2 + (h)) * HTB)
#define PG8_SB(b, h) ((4 + (b) * 2 + (h)) * HTB)
#define PG8_STAGE(bufoff, gbase, voff) do { _Pragma("unroll") for (int _i = 0; _i < 2; ++_i) \
        __builtin_amdgcn_global_load_lds((const unsigned*)((const char*)(gbase) + (voff)[_i]), (LAS unsigned*)(lds + (bufoff) + ldsw + _i * 8192), 16, 0, 0); } while (0)
#define PG8_LDA(dst, b, h) do { _Pragma("unroll") for (int m = 0; m < 4; ++m) _Pragma("unroll") for (int k = 0; k < 2; ++k) dst[m][k] = *(const LAS bf16x8*)(lds + PG8_SA(b, h) + aoff + m * 2048 + k * 1024); } while (0)
#define PG8_LDB(dst, b, h) do { _Pragma("unroll") for (int n = 0; n < 2; ++n) _Pragma("unroll") for (int k = 0; k < 2; ++k) dst[n][k] = *(const LAS bf16x8*)(lds + PG8_SB(b, h) + boff + n * 2048 + k * 1024); } while (0)
#define PG8_MMA(ai, bj, At, Bt) do { __builtin_amdgcn_s_setprio(1); _Pragma("unroll") for (int m = 0; m < 4; ++m) _Pragma("unroll") for (int n = 0; n < 2; ++n) _Pragma("unroll") for (int k = 0; k < 2; ++k) \
        acc[ai][bj][m][n] = __builtin_amdgcn_mfma_f32_16x16x32_bf16(Bt[n][k], At[m][k], acc[ai][bj][m][n], 0, 0, 0); __builtin_amdgcn_s_setprio(0); } while (0)
#define PG8_WAIT_V(n) asm volatile("s_waitcnt vmcnt(" #n ")" ::: "memory")
#define PG8_WAIT_L(n) asm volatile("s_waitcnt lgkmcnt(" #n ")" ::: "memory")
#define PG8_BAR __builtin_amdgcn_s_barrier()
#define PG8_SCHED __builtin_amdgcn_sched_barrier(0)
    Unit cur, nxt; int ui = 0;
    if (!S.next(0, cur)) return;
    f32x4 acc[2][2][4][2];
#pragma unroll
    for (int a = 0; a < 2; ++a)
#pragma unroll
        for (int b = 0; b < 2; ++b)
#pragma unroll
            for (int m = 0; m < 4; ++m)
#pragma unroll
                for (int n = 0; n < 2; ++n) acc[a][b][m][n] = (f32x4){0.f, 0.f, 0.f, 0.f};
    bf16x8 At[4][2], B0[2][2], B1[2][2];
    const char* cA = (const char*)g.A + (size_t)cur.pm * tstep; const char* cB = (const char*)g.Bt + (size_t)cur.pn * tstep;
    S.a_ready(cur);
    if constexpr (SP2) {
        PG8_STAGE(PG8_SB(0, 0), cB, voffB); PG8_STAGE(PG8_SB(0, 1), cB + hstep, voffB); PG8_STAGE(PG8_SA(0, 0), cA, voffA); PG8_STAGE(PG8_SA(0, 1), cA + hstep, voffA);
        if (wr == 1) PG8_BAR;
        PG8_WAIT_V(2); PG8_BAR;
        PG8_STAGE(PG8_SB(1, 0), cB + kstep, voffB); PG8_STAGE(PG8_SA(1, 0), cA + kstep, voffA); PG8_STAGE(PG8_SB(1, 1), cB + hstep + kstep, voffB);
        PG8_WAIT_V(6); PG8_BAR;
    } else {
        PG8_STAGE(PG8_SB(0, 0), cB, voffB); PG8_STAGE(PG8_SA(0, 0), cA, voffA); PG8_STAGE(PG8_SB(0, 1), cB + hstep, voffB); PG8_STAGE(PG8_SA(0, 1), cA + hstep, voffA);
        if (wr == 1) PG8_BAR;
        PG8_WAIT_V(4); PG8_BAR;
        PG8_STAGE(PG8_SB(1, 0), cB + kstep, voffB); PG8_STAGE(PG8_SA(1, 0), cA + kstep, voffA); PG8_STAGE(PG8_SB(1, 1), cB + hstep + kstep, voffB);
        PG8_WAIT_V(6); PG8_BAR;
    }
    for (;;) {
        const bool has_next = S.next(ui + 1, nxt);
        const char* nA = has_next ? (const char*)g.A + (size_t)nxt.pm * tstep : cA; const char* nB = has_next ? (const char*)g.Bt + (size_t)nxt.pn * tstep : cB;
        for (int t = 0; t < nt; t += 2) {
            const bool last = (t == nt - 2);
            const char* a1 = cA + (size_t)(t + 1) * kstep;
            const char* a2 = last ? nA : cA + (size_t)(t + 2) * kstep; const char* b2 = last ? nB : cB + (size_t)(t + 2) * kstep;
            const char* a3 = a2 + kstep; const char* b3 = b2 + kstep;
            if (last && has_next) S.a_ready(nxt);
            if constexpr (SP2) {
            PG8_LDB(B0, 0, 0); PG8_LDB(B1, 0, 1); PG8_SCHED; PG8_LDA(At, 0, 0); PG8_STAGE(PG8_SA(1, 1), a1 + hstep, voffA);
            PG8_WAIT_V(8); PG8_WAIT_L(0); PG8_BAR; PG8_MMA(0, 0, At, B0); PG8_MMA(0, 1, At, B1); PG8_BAR; PG8_SCHED;
            PG8_LDA(At, 0, 1); PG8_STAGE(PG8_SB(0, 0), b2, voffB); PG8_STAGE(PG8_SB(0, 1), b2 + hstep, voffB); PG8_STAGE(PG8_SA(0, 0), a2, voffA);
            PG8_WAIT_V(8); PG8_WAIT_L(0); PG8_BAR; PG8_MMA(1, 0, At, B0); PG8_MMA(1, 1, At, B1); PG8_BAR; PG8_SCHED;
            PG8_LDB(B0, 1, 0); PG8_LDB(B1, 1, 1); PG8_SCHED; PG8_LDA(At, 1, 0); PG8_STAGE(PG8_SA(0, 1), a2 + hstep, voffA);
            PG8_WAIT_V(8); PG8_WAIT_L(0); PG8_BAR; PG8_MMA(0, 0, At, B0); PG8_MMA(0, 1, At, B1); PG8_BAR; PG8_SCHED;
            PG8_LDA(At, 1, 1); PG8_STAGE(PG8_SB(1, 0), b3, voffB); PG8_STAGE(PG8_SB(1, 1), b3 + hstep, voffB); PG8_STAGE(PG8_SA(1, 0), a3, voffA);
            PG8_WAIT_V(8); PG8_WAIT_L(0); PG8_BAR; PG8_MMA(1, 0, At, B0); PG8_MMA(1, 1, At, B1); PG8_BAR; PG8_SCHED;
            } else {
            PG8_LDB(B0, 0, 0); PG8_SCHED; PG8_LDA(At, 0, 0); PG8_STAGE(PG8_SA(1, 1), a1 + hstep, voffA);
            PG8_WAIT_L(8); PG8_BAR; PG8_WAIT_L(0); PG8_MMA(0, 0, At, B0); PG8_BAR; PG8_SCHED;
            PG8_LDB(B1, 0, 1); PG8_STAGE(PG8_SB(0, 0), b2, voffB);
            PG8_BAR; PG8_WAIT_L(0); PG8_MMA(0, 1, At, B1); PG8_BAR;
            PG8_LDA(At, 0, 1); PG8_STAGE(PG8_SA(0, 0), a2, voffA);
            PG8_BAR; PG8_WAIT_L(0); PG8_MMA(1, 0, At, B0); PG8_BAR; PG8_SCHED;
            PG8_STAGE(PG8_SB(0, 1), b2 + hstep, voffB);
            PG8_WAIT_V(6); PG8_BAR; PG8_MMA(1, 1, At, B1); PG8_BAR;
            PG8_LDB(B0, 1, 0); PG8_SCHED; PG8_LDA(At, 1, 0); PG8_STAGE(PG8_SA(0, 1), a2 + hstep, voffA);
            PG8_WAIT_L(8); PG8_BAR; PG8_WAIT_L(0); PG8_MMA(0, 0, At, B0); PG8_BAR; PG8_SCHED;
            PG8_LDB(B1, 1, 1); PG8_STAGE(PG8_SB(1, 0), b3, voffB);
            PG8_BAR; PG8_WAIT_L(0); PG8_MMA(0, 1, At, B1); PG8_BAR;
            PG8_LDA(At, 1, 1); PG8_STAGE(PG8_SA(1, 0), a3, voffA);
            PG8_BAR; PG8_WAIT_L(0); PG8_MMA(1, 0, At, B0); PG8_BAR; PG8_SCHED;
            PG8_STAGE(PG8_SB(1, 1), b3 + hstep, voffB);
            PG8_WAIT_V(6); PG8_BAR; PG8_MMA(1, 1, At, B1); PG8_BAR;
            }
        }
        if constexpr (ALIGN_EPI) { if (wr == 0) PG8_BAR; }
        E(acc, cur, wr, wc, fr, fq); S.done(cur);
        if (!has_next) break;
#pragma unroll
        for (int a = 0; a < 2; ++a)
#pragma unroll
            for (int b = 0; b < 2; ++b)
#pragma unroll
                for (int m = 0; m < 4; ++m)
#pragma unroll
                    for (int n = 0; n < 2; ++n) acc[a][b][m][n] = (f32x4){0.f, 0.f, 0.f, 0.f};
        cur = nxt; cA = nA; cB = nB; ++ui;
        if constexpr (ALIGN_EPI) { if (wr == 1) PG8_BAR; }
    }
    PG8_WAIT_V(0);
    if constexpr (!ALIGN_EPI) { if (wr == 0) PG8_BAR; }
    PG8_BAR;
#undef PG8_SA
#undef PG8_SB
#undef PG8_STAGE
#undef PG8_LDA
#undef PG8_LDB
#undef PG8_MMA
#undef PG8_WAIT_V
#undef PG8_WAIT_L
#undef PG8_BAR
#undef PG8_SCHED
}
}

#ifndef PG8_SP2
#define PG8_SP2 true
#endif
#ifndef PG8_ALIGN
#define PG8_ALIGN true
#endif

constexpr int NWAVES = 8, NTHREADS = NWAVES * 64;
constexpr int RING_BYTES = 131072, LDSCTL_OFF = RING_BYTES, LDS_BYTES = 147456;
constexpr int N_PHASES = 9;

__device__ __forceinline__ unsigned f2bf(float f) { unsigned u = __builtin_bit_cast(unsigned, f); return (u + 0x7fffu + ((u >> 16) & 1u)) >> 16; }
__device__ __forceinline__ unsigned pk2(float lo, float hi) { return f2bf(lo) | (f2bf(hi) << 16); }
__device__ __forceinline__ float bf2f(unsigned short b) { return __builtin_bit_cast(float, (unsigned)b << 16); }
__device__ __forceinline__ float wave_sum(float v) {
#pragma unroll
    for (int o = 1; o < 64; o <<= 1) v += __shfl_xor(v, o);
    return v;
}

#define XB_TMO      128
#define XB_XCNT(j)  (256  + 64 * (j))
#define XB_XSUB(j)  (1280 + 64 * (j))
#define XB_XGEN(j)  (2304 + 64 * (j))
#define XB_TOP      3328
#define XB_TOPGEN   3392
#define XCD_BAR_WORDS 3456
#define XB_SPIN_CAP (1u << 22)
__device__ __forceinline__ unsigned xb_ld(unsigned* p)              { return __hip_atomic_load(p, __ATOMIC_RELAXED, __HIP_MEMORY_SCOPE_AGENT); }
__device__ __forceinline__ unsigned xb_add(unsigned* p, unsigned v) { return __hip_atomic_fetch_add(p, v, __ATOMIC_RELAXED, __HIP_MEMORY_SCOPE_AGENT); }
__device__ __forceinline__ unsigned xb_xcc_id() { return (unsigned)__builtin_amdgcn_s_getreg((3 << 11) | 20) & 0xFu; }
#define XB_SPIN(cond, bar) do { unsigned _sp = 0; while (cond) { __builtin_amdgcn_s_sleep(1); \
    if ((++_sp & 255u) == 0u) { if (xb_ld(&(bar)[XB_TMO])) break; if (_sp > XB_SPIN_CAP) { atomicAdd(&(bar)[XB_TMO], 1u); break; } } } } while (0)
struct XcdBarrier { unsigned* bar; unsigned x; volatile LAS unsigned* st; };
__device__ __forceinline__ XcdBarrier xcd_barrier_post(unsigned* bar, volatile LAS unsigned* st) {
    XcdBarrier b; b.bar = bar; b.x = xb_xcc_id(); b.st = st;
    if (threadIdx.x == 0) (void)xb_add(&bar[XB_XCNT(b.x)], 1u);
    return b;
}
__device__ __forceinline__ void xcd_barrier_complete(unsigned* bar, unsigned x, unsigned& nloc, unsigned& nx) {
    const unsigned G = gridDim.x * gridDim.y * gridDim.z;
    unsigned sum, cnt, mine, sp = 0u;
    for (;;) {
        sum = 0u; cnt = 0u; mine = 0u;
#pragma unroll
        for (unsigned j = 0; j < 16; ++j) { const unsigned c = xb_ld(&bar[XB_XCNT(j)]); sum += c; cnt += (c > 0u) ? 1u : 0u; mine = (j == x) ? c : mine; }
        if (sum == G) break;
        __builtin_amdgcn_s_sleep(1);
        if ((++sp & 255u) == 0u) { if (xb_ld(&bar[XB_TMO])) break; if (sp > XB_SPIN_CAP) { atomicAdd(&bar[XB_TMO], 1u); break; } }
    }
    nloc = mine > 0u ? mine : 1u; nx = cnt > 0u ? cnt : 1u;
}
__device__ __forceinline__ void xcd_barrier(const XcdBarrier& b) {
    asm volatile("s_waitcnt vmcnt(0)" ::: "memory");
    __syncthreads();
    if (threadIdx.x == 0) {
        unsigned* bar = b.bar;
        __builtin_amdgcn_s_waitcnt(0);
        unsigned nloc = b.st[0], nx = b.st[1];
        if (nloc == 0u) { xcd_barrier_complete(bar, b.x, nloc, nx); b.st[0] = nloc; b.st[1] = nx; }
        const unsigned old = xb_add(&bar[XB_XSUB(b.x)], 1u);
        const unsigned gen = old / nloc;
        if (old + 1u == (gen + 1u) * nloc) {
            __builtin_amdgcn_fence(__ATOMIC_RELEASE, "agent");
            asm volatile("s_waitcnt vmcnt(0)" ::: "memory");
            const unsigned og = xb_add(&bar[XB_TOP], 1u);
            const unsigned tg = og / nx;
            if (og + 1u == (tg + 1u) * nx) xb_add(&bar[XB_TOPGEN], 1u);
            else XB_SPIN(xb_ld(&bar[XB_TOPGEN]) == tg, bar);
            __builtin_amdgcn_fence(__ATOMIC_ACQUIRE, "agent");
            xb_add(&bar[XB_XGEN(b.x)], 1u);
            asm volatile("s_waitcnt vmcnt(0)" ::: "memory");
        } else {
            XB_SPIN(xb_ld(&bar[XB_XGEN(b.x)]) == gen, bar);
            __builtin_amdgcn_fence(__ATOMIC_ACQUIRE, "agent");
            asm volatile("s_waitcnt vmcnt(0)" ::: "memory");
        }
    }
    __syncthreads();
}

struct Args {
    const float* in[25];
    float* out; unsigned char* ws;
    int ph_lo, ph_hi, use_cg, pad;
};
enum { I_XP = 0, I_XS, I_SC, I_SP, I_META, I_G1, I_W1G, I_W1U, I_W1D, I_GM, I_WIN, I_BIN, I_WDW, I_BDW, I_LNG, I_LNB, I_WPOOL, I_PSCALE, I_WOUT, I_BOUT, I_G2, I_W2G, I_W2U, I_W2D, I_GF };
constexpr size_t O_YP = 0, O_YS = (size_t)NB * SEQ * D, O_CP = O_YS + (size_t)MSA * D, O_PP = O_CP + (size_t)NB * CH * CC, O_CS = O_PP + (size_t)NB * PH * CPL, O_PS = O_CS + (size_t)NSB * CH * CC, O_END = O_PS + (size_t)NSB * PH * CPL;

__device__ __forceinline__ void transpose_item(const float* W, int K, int N, const float* gain, bf16_t* WT, int dest_row0, int k0, int n0, LAS float* scr, int lane) {
#pragma unroll 8
    for (int i = 0; i < 32; ++i) { const int kk = 2 * i + (lane >> 5); float v = W[(size_t)(k0 + kk) * N + n0 + (lane & 31)]; if (gain) v *= gain[k0 + kk]; scr[kk * 33 + (lane & 31)] = v; }
    asm volatile("s_waitcnt lgkmcnt(0)" ::: "memory");
    const int c = lane & 7;
#pragma unroll
    for (int j = 0; j < 4; ++j) { const int n = (lane >> 3) + 8 * j; const LAS float* s = scr + (8 * c) * 33 + n;
        u32x4 o; o.x = pk2(s[0 * 33], s[1 * 33]); o.y = pk2(s[2 * 33], s[3 * 33]); o.z = pk2(s[4 * 33], s[5 * 33]); o.w = pk2(s[6 * 33], s[7 * 33]);
        *(u32x4*)(WT + (size_t)(dest_row0 + n) * K + k0 + 8 * c) = o; }
    asm volatile("s_waitcnt lgkmcnt(0)" ::: "memory");
}

__device__ __forceinline__ const float* x0_row(const Args& a, int row) {
    if (row < MPR) { const int b = row / TP, t = row - b * TP; return t < NMETA ? a.in[I_META] + (size_t)t * D : a.in[I_XP] + ((size_t)b * SEQ + (t - NMETA)) * D; }
    return a.in[I_XS] + (size_t)(row - MPR) * D;
}

__device__ __forceinline__ void prep_phase(const Args& a, LAS unsigned char* lds, int gw, int NGW, int wave, int lane) {
    unsigned char* ws = a.ws;
    LAS float* scr = (LAS float*)(lds + wave * 16384);
    constexpr int I_FFN_GU = (D / 64) * (FF / 32);
    constexpr int I_FFN_D = (FF / 64) * (D / 32);
    constexpr int I_WIN_ = (D / 64) * (DIN / 32);
    constexpr int I_WOUT_ = (CC / 64) * (D / 32);
    constexpr int NITEMS = 6 * I_FFN_GU + I_WIN_ + I_WOUT_;
    static_assert(I_FFN_GU == I_FFN_D, "items");
    for (int it = gw; it < NITEMS; it += NGW) {
        int r = it;
        if (r < 6 * I_FFN_GU) {
            const int which = r / I_FFN_GU; r -= which * I_FFN_GU;
            const int ffn = which / 3, part = which % 3;
            if (part < 2) {
                const float* W = a.in[(ffn ? I_W2G : I_W1G) + part]; const float* gain = a.in[ffn ? I_G2 : I_G1];
                bf16_t* WT = (bf16_t*)(ws + (ffn ? WS_W2C : WS_W1C));
                const int nblk = FF / 32, kb = r / nblk, nb = r % nblk, n0 = nb * 32;
                const int dest = (n0 / 128) * 256 + part * 128 + (n0 % 128);
                transpose_item(W, D, FF, gain, WT, dest, kb * 64, n0, scr, lane);
            } else {
                const float* W = a.in[ffn ? I_W2D : I_W1D]; bf16_t* WT = (bf16_t*)(ws + (ffn ? WS_W2D : WS_W1D));
                const int nblk = D / 32, kb = r / nblk, nb = r % nblk;
                transpose_item(W, FF, D, nullptr, WT, nb * 32, kb * 64, nb * 32, scr, lane);
            }
            continue;
        }
        r -= 6 * I_FFN_GU;
        if (r < I_WIN_) {
            const int nblk = DIN / 32, kb = r / nblk, nb = r % nblk, n0 = nb * 32;
            int dest;
            if (n0 < CC) dest = (n0 / 128) * 256 + (n0 % 128);
            else if (n0 < 2 * CC) dest = ((n0 - CC) / 128) * 256 + 128 + (n0 % 128);
            else dest = n0;
            transpose_item(a.in[I_WIN], D, DIN, a.in[I_GM], (bf16_t*)(ws + WS_WIN), dest, kb * 64, n0, scr, lane);
            continue;
        }
        r -= I_WIN_;
        { const int nblk = D / 32, kb = r / nblk, nb = r % nblk;
          transpose_item(a.in[I_WOUT], D, D, nullptr, (bf16_t*)(ws + WS_WOUT), nb * 32, kb * 64, nb * 32, scr, lane); }
    }
    {
        const float* wp = a.in[I_WPOOL]; const float* ps = a.in[I_PSCALE]; const float* wo = a.in[I_WOUT]; bf16_t* WT = (bf16_t*)(ws + WS_WOUT);
        for (int it = gw; it < 1024; it += NGW) {
            const int g = it >> 8, cb = (it >> 4) & 15, nb = it & 15, n = nb * 64 + lane;
            float accv[8];
#pragma unroll
            for (int j = 0; j < 8; ++j) accv[j] = 0.f;
            for (int d = 0; d < PG; ++d) {
                const float wv = wo[(size_t)(CC + g * PG + d) * D + n] * ps[g * PG + d];
#pragma unroll
                for (int j = 0; j < 8; ++j) accv[j] += wp[((size_t)g * PG + cb * 8 + j) * PG + d] * wv;
            }
            *(u32x4*)(WT + (size_t)n * D + CC + g * PG + cb * 8) = (u32x4){pk2(accv[0], accv[1]), pk2(accv[2], accv[3]), pk2(accv[4], accv[5]), pk2(accv[6], accv[7])};
        }
    }
    {
        float* X = (float*)(ws + WS_X); bf16_t* XB = (bf16_t*)(ws + WS_XB);
        for (int row = gw; row < MP; row += NGW) {
            f32x4 v[4];
            if (row < M) { const f32x4* xr = (const f32x4*)x0_row(a, row) + lane;
#pragma unroll
                for (int j = 0; j < 4; ++j) v[j] = xr[64 * j]; }
            else {
#pragma unroll
                for (int j = 0; j < 4; ++j) v[j] = (f32x4){0.f, 0.f, 0.f, 0.f}; }
            float s = 0.f;
#pragma unroll
            for (int j = 0; j < 4; ++j) s += (v[j].x * v[j].x + v[j].y * v[j].y) + (v[j].z * v[j].z + v[j].w * v[j].w);
            const float r = __builtin_amdgcn_rsqf(wave_sum(s) * (1.0f / D) + EPS);
            f32x4* xo = (f32x4*)(X + (size_t)row * D) + lane; u32x2* bo = (u32x2*)(XB + (size_t)row * D) + lane;
#pragma unroll
            for (int j = 0; j < 4; ++j) { xo[64 * j] = v[j]; bo[64 * j] = (u32x2){pk2(v[j].x * r, v[j].y * r), pk2(v[j].z * r, v[j].w * r)}; }
        }
    }
}

constexpr int MIX_R = 32;
constexpr int NCH_P = (TP + MIX_R - 1) / MIX_R;
constexpr int N_CHUNKS = NB * NCH_P + NSB;
__device__ __forceinline__ void mixer_phase(const Args& a, LAS unsigned char* lds, int vcu, int G, int tid, int wave, int lane) {
    unsigned char* ws = a.ws;
    const bf16_t* UP = (const bf16_t*)(ws + WS_UP); bf16_t* A4 = (bf16_t*)(ws + WS_A4);
    LAS float* Cb = (LAS float*)lds;
    LAS unsigned short* Db = (LAS unsigned short*)(lds + 65536);
    const int c = tid;
    float w[CW];
#pragma unroll
    for (int k = 0; k < CW; ++k) w[k] = a.in[I_WDW][k * CC + c];
    const float bdw = a.in[I_BDW][c];
    const int pgrp = c >> 7;
    const float* lng = a.in[I_LNG]; const float* lnb = a.in[I_LNB];
    for (int ch = vcu; ch < N_CHUNKS; ch += G) {
        const bool samp = ch >= NB * NCH_P;
        int rowbase, t0, nrows, pos0; const float* hc = nullptr; const float* hp = nullptr;
        if (!samp) { const int b = ch / NCH_P, j = ch - b * NCH_P; t0 = j * MIX_R; nrows = (TP - t0) < MIX_R ? (TP - t0) : MIX_R; rowbase = b * TP; pos0 = t0; }
        else { const int b = ch - NB * NCH_P; t0 = 0; nrows = TS; rowbase = MPR + b * TS; pos0 = PAST_LEN; hc = a.in[I_SC] + (size_t)b * CH * CC; hp = a.in[I_SP] + (size_t)b * PH * CPL; }
        float win[CH + 8], pw[PH + 8];
#pragma unroll
        for (int j = 0; j < CH; ++j) {
            const int t = t0 - CH + j;
            float v = 0.f;
            if (samp) v = hc[j * CC + c];
            else if (t >= 0) v = bf2f(UP[(size_t)(rowbase + t) * 1024 + c]);
            win[j] = v;
        }
#pragma unroll
        for (int j = 0; j < PH; ++j) {
            const int t = t0 - PH + j;
            float v = 0.f;
            if (samp) v = hp[j * CPL + c];
            else if (t >= 0) v = bf2f(UP[(size_t)(rowbase + t) * 1024 + CC + c]);
            pw[j] = v;
        }
        const int ngrp = (nrows + 7) >> 3;
        for (int g = 0; g < ngrp; ++g) {
#pragma unroll
            for (int i = 0; i < 8; ++i) {
                const int t = g * 8 + i; float vu = 0.f, vp = 0.f;
                if (t < nrows) { const bf16_t* rp = UP + (size_t)(rowbase + t0 + t) * 1024; vu = bf2f(rp[c]); vp = bf2f(rp[CC + c]); }
                win[CH + i] = vu; pw[PH + i] = vp;
            }
#pragma unroll
            for (int i = 0; i < 8; ++i) {
                float o = bdw;
#pragma unroll
                for (int k = 0; k < CW; ++k) o += w[k] * win[i + k];
                Cb[(g * 8 + i) * CC + c] = o;
                const float* q = pw + PH + i;
                const float s2 = q[0] + q[-1];
                const float s4 = s2 + (q[-2] + q[-3]);
                const float s8 = s4 + ((q[-4] + q[-5]) + (q[-6] + q[-7]));
                const float s16 = s8 + (((q[-8] + q[-9]) + (q[-10] + q[-11])) + ((q[-12] + q[-13]) + (q[-14] + q[-15])));
                const float ssel = pgrp == 0 ? s2 : (pgrp == 1 ? s4 : (pgrp == 2 ? s8 : s16));
                const int wlen = 2 << pgrp; const int pos = pos0 + g * 8 + i;
                const float cnt = (float)((pos + 1) < wlen ? (pos + 1) : wlen);
                const float dv = ssel / cnt - q[0];
                Db[(g * 8 + i) * CPL + c] = (unsigned short)f2bf(dv);
            }
#pragma unroll
            for (int j = 0; j < CH; ++j) win[j] = win[j + 8];
#pragma unroll
            for (int j = 0; j < PH; ++j) pw[j] = pw[j + 8];
        }
        __syncthreads();
        for (int rr = wave; rr < nrows; rr += NWAVES) {
            const f32x4 v0 = *(const LAS f32x4*)(Cb + rr * CC + 8 * lane), v1 = *(const LAS f32x4*)(Cb + rr * CC + 8 * lane + 4);
            const float mean = wave_sum((v0.x + v0.y) + (v0.z + v0.w) + (v1.x + v1.y) + (v1.z + v1.w)) * (1.0f / CC);
            const f32x4 d0 = v0 - mean, d1 = v1 - mean;
            const float var = wave_sum((d0.x * d0.x + d0.y * d0.y) + (d0.z * d0.z + d0.w * d0.w) + (d1.x * d1.x + d1.y * d1.y) + (d1.z * d1.z + d1.w * d1.w)) * (1.0f / CC);
            const float rstd = __builtin_amdgcn_rsqf(var + EPS);
            const f32x4 g0 = *(const f32x4*)(lng + 8 * lane), g1 = *(const f32x4*)(lng + 8 * lane + 4), b0 = *(const f32x4*)(lnb + 8 * lane), b1 = *(const f32x4*)(lnb + 8 * lane + 4);
            f32x4 y0 = d0 * rstd * g0 + b0, y1 = d1 * rstd * g1 + b1;
#pragma unroll
            for (int j = 0; j < 4; ++j) { y0[j] = y0[j] * pg8::sigmoidf_(y0[j]); y1[j] = y1[j] * pg8::sigmoidf_(y1[j]); }
            bf16_t* orow = A4 + (size_t)(rowbase + t0 + rr) * 1024;
            *(u32x4*)(orow + 8 * lane) = (u32x4){pk2(y0.x, y0.y), pk2(y0.z, y0.w), pk2(y1.x, y1.y), pk2(y1.z, y1.w)};
            *(u32x4*)(orow + CC + 8 * lane) = *(const LAS u32x4*)(Db + rr * CPL + 8 * lane);
        }
        __syncthreads();
    }
    for (int i = vcu * NTHREADS + tid; i < (MP - M) * 1024 / 8; i += G * NTHREADS) *(u32x4*)(A4 + (size_t)M * 1024 + (size_t)i * 8) = (u32x4){0u, 0u, 0u, 0u};
    {
        float* out = a.out;
        const int gt = vcu * NTHREADS + tid, GT = G * NTHREADS;
        for (int i = gt; i < NB * CH * CC; i += GT) { const int cch = i % CC, j = (i / CC) % CH, b = i / (CC * CH); out[O_CP + i] = bf2f(UP[(size_t)(b * TP + TP - CH + j) * 1024 + cch]); }
        for (int i = gt; i < NB * PH * CPL; i += GT) { const int cch = i % CPL, j = (i / CPL) % PH, b = i / (CPL * PH); out[O_PP + i] = bf2f(UP[(size_t)(b * TP + TP - PH + j) * 1024 + CC + cch]); }
        for (int i = gt; i < NSB * CH * CC; i += GT) { const int cch = i % CC, j = (i / CC) % CH, b = i / (CC * CH);
            out[O_CS + i] = (j < CH - TS) ? a.in[I_SC][((size_t)b * CH + j + TS) * CC + cch] : bf2f(UP[(size_t)(MPR + b * TS + (j - (CH - TS))) * 1024 + cch]); }
        for (int i = gt; i < NSB * PH * CPL; i += GT) { const int cch = i % CPL, j = (i / CPL) % PH, b = i / (CPL * PH);
            out[O_PS + i] = (j < PH - TS) ? a.in[I_SP][((size_t)b * PH + j + TS) * CPL + cch] : bf2f(UP[(size_t)(MPR + b * TS + (j - (PH - TS))) * 1024 + CC + cch]); }
    }
}

__device__ __forceinline__ void final_phase(const Args& a, int gw, int NGW, int lane) {
    const float* X = (const float*)(a.ws + WS_X); const float* ssq = (const float*)(a.ws + WS_SSQ3); const float* gf = a.in[I_GF];
    f32x4 gv[4];
#pragma unroll
    for (int j = 0; j < 4; ++j) gv[j] = *((const f32x4*)gf + lane + 64 * j);
    constexpr int NOUT = NB * SEQ + MSA;
    for (int o = gw; o < NOUT; o += NGW) {
        int row; float* dst;
        if (o < NB * SEQ) { const int b = o / SEQ, t = o - b * SEQ; row = b * TP + NMETA + t; dst = a.out + O_YP + (size_t)o * D; }
        else { row = MPR + (o - NB * SEQ); dst = a.out + O_YS + (size_t)(o - NB * SEQ) * D; }
        const f32x4* sp = (const f32x4*)(ssq + (size_t)row * 16);
        const f32x4 p0 = sp[0], p1 = sp[1], p2 = sp[2], p3 = sp[3];
        const float s = (((p0.x + p0.y) + (p0.z + p0.w)) + ((p1.x + p1.y) + (p1.z + p1.w))) + (((p2.x + p2.y) + (p2.z + p2.w)) + ((p3.x + p3.y) + (p3.z + p3.w)));
        const float r = __builtin_amdgcn_rsqf(s * (1.0f / D) + EPS);
        const f32x4* xr = (const f32x4*)(X + (size_t)row * D) + lane; f32x4* yo = (f32x4*)dst + lane;
#pragma unroll
        for (int j = 0; j < 4; ++j) yo[64 * j] = xr[64 * j] * r * gv[j];
    }
}

__global__ void __launch_bounds__(NTHREADS, 2) mk_fwd(Args args) {
    extern __shared__ __attribute__((aligned(16))) unsigned char lds_raw[];
    LAS unsigned char* lds = (LAS unsigned char*)lds_raw;
    volatile LAS unsigned* MISC = (volatile LAS unsigned*)(lds + LDSCTL_OFF);
    const int tid = threadIdx.x, lane = tid & 63, wave = __builtin_amdgcn_readfirstlane(tid >> 6);
    const int G = gridDim.x; const int bx = blockIdx.x; const int vcu = (G % 8 == 0) ? (bx % 8) * (G / 8) + bx / 8 : bx;
    const int gw = vcu * NWAVES + wave, NGW = G * NWAVES;
    unsigned char* ws = args.ws;
    if (tid < 64) MISC[tid] = 0u;
    __syncthreads();
    XcdBarrier bar; bar.bar = (unsigned*)(ws + WS_CTL) + 1024; bar.x = 0; bar.st = nullptr;
    if (MK_N_LAUNCHES == 1) bar = xcd_barrier_post((unsigned*)(ws + WS_CTL) + 1024, MISC + 8);
    const int lo = args.ph_lo, hi = args.ph_hi;
#define IN(k) (lo <= (k) && (k) < hi)
#define BOTH(k) (IN(k) && IN((k) + 1))
#define GRID_BAR() do { if (args.use_cg) { cg::this_grid().sync(); } else { xcd_barrier(bar); } } while (0)

    bf16_t* XB = (bf16_t*)(ws + WS_XB); float* X = (float*)(ws + WS_X); bf16_t* R1 = (bf16_t*)(ws + WS_R1);
    float* SSQ1 = (float*)(ws + WS_SSQ1); float* SSQ2 = (float*)(ws + WS_SSQ2); float* SSQ3 = (float*)(ws + WS_SSQ3);

    if (IN(0)) { prep_phase(args, lds, gw, NGW, wave, lane); if (BOTH(0)) { cg::this_grid().sync(); } }

    if (IN(1)) {
        pg8::Gemm g{XB, (const bf16_t*)(ws + WS_W1C), MP, 2 * FF, D}; pg8::StaticOrder S; S.init(MP, 2 * FF, G, bx);
        pg8::EpiSwiglu<false> E{R1, nullptr};
        pg8::gemm_phase<pg8::EpiSwiglu<false>, pg8::StaticOrder, PG8_ALIGN, PG8_SP2>(lds, g, S, E);
        if (BOTH(1)) GRID_BAR();
    }
    if (IN(2)) {
        pg8::Gemm g{R1, (const bf16_t*)(ws + WS_W1D), MP, D, FF}; pg8::StaticOrder S; S.init(MP, D, G, bx);
        pg8::EpiResid<false, true> E{X, XB, SSQ1, nullptr, 0.5f};
        pg8::gemm_phase<pg8::EpiResid<false, true>, pg8::StaticOrder, PG8_ALIGN, PG8_SP2>(lds, g, S, E);
        if (BOTH(2)) GRID_BAR();
    }
    if (IN(3)) {
        pg8::Gemm g{XB, (const bf16_t*)(ws + WS_WIN), MP, DIN, D}; pg8::StaticOrder S; S.init(MP, DIN, G, bx);
        pg8::EpiWin E{(bf16_t*)(ws + WS_UP), SSQ1, args.in[I_BIN]};
        pg8::gemm_phase<pg8::EpiWin, pg8::StaticOrder, PG8_ALIGN, PG8_SP2>(lds, g, S, E);
        if (BOTH(3)) GRID_BAR();
    }
    if (IN(4)) { mixer_phase(args, lds, vcu, G, tid, wave, lane); if (BOTH(4)) GRID_BAR(); }
    if (IN(5)) {
        pg8::Gemm g{(const bf16_t*)(ws + WS_A4), (const bf16_t*)(ws + WS_WOUT), MP, D, D}; pg8::StaticOrder S; S.init(MP, D, G, bx);
        pg8::EpiResid<true, true> E{X, XB, SSQ2, args.in[I_BOUT], 1.0f};
        pg8::gemm_phase<pg8::EpiResid<true, true>, pg8::StaticOrder, PG8_ALIGN, PG8_SP2>(lds, g, S, E);
        if (BOTH(5)) GRID_BAR();
    }
    if (IN(6)) {
        pg8::Gemm g{XB, (const bf16_t*)(ws + WS_W2C), MP, 2 * FF, D}; pg8::StaticOrder S; S.init(MP, 2 * FF, G, bx);
        pg8::EpiSwiglu<true> E{R1, SSQ2};
        pg8::gemm_phase<pg8::EpiSwiglu<true>, pg8::StaticOrder, PG8_ALIGN, PG8_SP2>(lds, g, S, E);
        if (BOTH(6)) GRID_BAR();
    }
    if (IN(7)) {
        pg8::Gemm g{R1, (const bf16_t*)(ws + WS_W2D), MP, D, FF}; pg8::StaticOrder S; S.init(MP, D, G, bx);
        pg8::EpiResid<false, false> E{X, nullptr, SSQ3, nullptr, 0.5f};
        pg8::gemm_phase<pg8::EpiResid<false, false>, pg8::StaticOrder, PG8_ALIGN, PG8_SP2>(lds, g, S, E);
        if (BOTH(7)) GRID_BAR();
    }
    if (IN(8)) final_phase(args, gw, NGW, lane);
#undef IN
#undef BOTH
#undef GRID_BAR
}

extern "C" void kernel_launch(void* const* d_in, const int* in_sizes, int n_in, void* d_out, int out_size, void* d_ws, size_t ws_size, hipStream_t stream) {
    static int grid = 0;
    if (grid == 0) {
        if (n_in != 25 || (size_t)out_size != O_END || ws_size < WS_END) { fprintf(stderr, "kernel_launch: unexpected shapes (n_in %d out %d ws %zu)\n", n_in, out_size, ws_size); grid = -1; return; }
        int dev = 0, cus = 0, per_cu = 0;
        if (hipGetDevice(&dev) != hipSuccess || hipDeviceGetAttribute(&cus, hipDeviceAttributeMultiprocessorCount, dev) != hipSuccess) { grid = -1; return; }
        if (hipFuncSetAttribute((const void*)mk_fwd, hipFuncAttributeMaxDynamicSharedMemorySize, LDS_BYTES) != hipSuccess) { fprintf(stderr, "kernel_launch: hipFuncSetAttribute failed\n"); grid = -1; return; }
        if (hipOccupancyMaxActiveBlocksPerMultiprocessor(&per_cu, (const void*)mk_fwd, NTHREADS, LDS_BYTES) != hipSuccess || per_cu < 1) { fprintf(stderr, "kernel_launch: occupancy query says %d\n", per_cu); per_cu = 1; }
        (void)hipGetLastError();
        grid = cus * 1;
    }
    if (grid < 0) return;
    (void)hipMemsetAsync((char*)d_ws + WS_CTL, 0, CTL_ZERO_BYTES, stream);
    Args a{};
    for (int i = 0; i < 25; ++i) a.in[i] = (const float*)d_in[i];
    a.out = (float*)d_out; a.ws = (unsigned char*)d_ws;
    if (MK_N_LAUNCHES == 1) {
        a.ph_lo = 0; a.ph_hi = N_PHASES; a.use_cg = 0;
        void* kargs[] = {&a};
        hipError_t e = hipLaunchCooperativeKernel((const void*)mk_fwd, dim3(grid), dim3(NTHREADS), kargs, LDS_BYTES, stream);
        if (e != hipSuccess) fprintf(stderr, "kernel_launch: cooperative launch failed: %s (grid %d)\n", hipGetErrorString(e), grid);
    } else {
        for (int p = 0; p < N_PHASES; ++p) {
            a.ph_lo = p; a.ph_hi = p + 1; a.use_cg = 0;
            hipLaunchKernelGGL(mk_fwd, dim3(grid), dim3(NTHREADS), LDS_BYTES, stream, a);
        }
    }
}
```

```cpp
#include <hip/hip_runtime.h>
#include <hip/hip_cooperative_groups.h>
#include <cstdio>
#include <cstdint>
namespace cg = cooperative_groups;

#ifndef MK_N_LAUNCHES
#define MK_N_LAUNCHES 1
#endif

#define LAS __attribute__((address_space(3)))
typedef unsigned short bf16_t;
typedef short bf16x8 __attribute__((ext_vector_type(8)));
typedef float f32x4 __attribute__((ext_vector_type(4)));
typedef unsigned u32x4 __attribute__((ext_vector_type(4)));
typedef unsigned u32x2 __attribute__((ext_vector_type(2)));

constexpr int D = 1024, FF = 2816, NB = 8, NMETA = 16, SEQ = 2048, TP = NMETA + SEQ  , MPR = NB * TP  ;
constexpr int NSB = 128, TS = 4, MSA = NSB * TS  , M = MPR + MSA  , MP = 17152  ;
constexpr int CC = 512, CPL = 512, DIN = 1536, CW = 31, CH = 30, PH = 15, PG = 128;
constexpr float EPS = 1e-6f;
constexpr int PAST_LEN = 16384;

constexpr size_t MiB = 1u << 20;
constexpr size_t WS_CTL = 0, CTL_ZERO_BYTES = 64 * 1024;
constexpr size_t WS_SSQ1 = 1 * MiB, WS_SSQ2 = 1 * MiB + 1280 * 1024, WS_SSQ3 = 1 * MiB + 2560 * 1024;
constexpr size_t WS_W1C = 6 * MiB, WS_W1D = 17 * MiB, WS_WIN = 22 * MiB + 512 * 1024, WS_WOUT = 25 * MiB + 512 * 1024, WS_W2C = 27 * MiB + 512 * 1024, WS_W2D = 38 * MiB + 512 * 1024;
constexpr size_t WS_XB = 44 * MiB;
constexpr size_t WS_X = 78 * MiB;
constexpr size_t WS_R1 = 145 * MiB;
constexpr size_t WS_UP = WS_R1, WS_A4 = WS_R1 + 34 * MiB;
constexpr size_t WS_END = WS_R1 + (size_t)MP * FF * 2;
static_assert(WS_END <= 256 * MiB, "ws map");
static_assert(WS_SSQ3 + (size_t)MP * 64 <= WS_W1C && WS_XB + (size_t)MP * D * 2 <= WS_X && WS_X + (size_t)MP * D * 4 <= WS_R1 && WS_A4 + (size_t)MP * D * 2 <= WS_END, "ws map 2");

namespace pg8 {
constexpr int BM = 256, BK = 64, HALF = 128, HTB = HALF * BK * 2, STAGE_BYTES = 8 * HTB, NXCD = 8, WGM = 8;
__host__ __device__ __forceinline__ int lds_byte(int r, int c) { const int st = (r >> 4) * 2 + (c >> 5), rr = r & 15, cc = c & 31, ob = rr * 64 + cc * 2; return st * 1024 + (ob ^ (((ob >> 9) & 1) << 5)); }
__host__ __device__ __forceinline__ void stage_rc(int b, int& R, int& C) { const int st = b / 1024, sb = b % 1024, swz = sb ^ (((sb >> 9) & 1) << 5); R = (st >> 1) * 16 + swz / 64; C = (st & 1) * 32 + (swz % 64) / 2; }
__host__ __device__ __forceinline__ int perm32(int rho) { const int n = rho >> 4, i = rho & 15; return 8 * (i >> 2) + 4 * n + (i & 3); }

struct Unit { int pm, pn; };
struct Gemm { const bf16_t* A; const bf16_t* Bt; int M, N, K; };

struct StaticOrder {
    int nM, nN, nwg, G, c;
    __device__ void init(int M_, int N_, int G_, int c_) { nM = M_ / BM; nN = N_ / BM; nwg = nM * nN; G = G_; c = c_; }
    __device__ bool next(int i, Unit& u) const {
        const long L = (long)i * G + c; if (L >= nwg) return false;
        int wgid = (int)L; { const int q = nwg / NXCD, r = nwg % NXCD, xcd = wgid % NXCD, off = wgid / NXCD; wgid = (xcd < r ? xcd * (q + 1) : r * (q + 1) + (xcd - r) * q) + off; }
        const int nig = WGM * nN, gid = wgid / nig, fm = gid * WGM, gsz = (nM - fm) < WGM ? (nM - fm) : WGM;
        u.pm = fm + ((wgid % nig) % gsz); u.pn = (wgid % nig) / gsz; return true;
    }
    __device__ __forceinline__ void a_ready(const Unit&) const {}
    __device__ __forceinline__ void done(const Unit&) const {}
};

__device__ __forceinline__ unsigned cvt_pk_bf16(float lo, float hi) { unsigned r; asm volatile("v_cvt_pk_bf16_f32 %0, %1, %2" : "=v"(r) : "v"(lo), "v"(hi)); return r; }
__device__ __forceinline__ float sigmoidf_(float x) { return __builtin_amdgcn_rcpf(1.0f + __builtin_amdgcn_exp2f(-1.44269504089f * x)); }

__device__ __forceinline__ float row_rs(const float* ssq, int row, int fq) {
    const f32x4 p = *(const f32x4*)(ssq + (size_t)row * 16 + 4 * fq);
    float s = (p.x + p.y) + (p.z + p.w);
    s += __shfl_xor(s, 16); s += __shfl_xor(s, 32);
    return __builtin_amdgcn_rsqf(s * (1.0f / D) + EPS);
}


template <bool SCALE> struct EpiSwiglu {
    static constexpr bool PERM = true, AFTER_DRAIN = false;
    bf16_t* O; const float* ssq;
    __device__ __forceinline__ void operator()(const f32x4 (&acc)[2][2][4][2], const Unit& u, int wr, int wc, int fr, int fq) const {
        const int row0 = u.pm * BM + wr * 64 + fr, col0 = u.pn * HALF + wc * 32 + 8 * fq;
#pragma unroll
        for (int ai = 0; ai < 2; ++ai)
#pragma unroll
            for (int m = 0; m < 4; ++m) {
                const int row = row0 + ai * HALF + m * 16;
                float r = 1.0f; if (SCALE) r = row_rs(ssq, row, fq);
                unsigned w[4];
#pragma unroll
                for (int n = 0; n < 2; ++n) {
                    f32x4 g = acc[ai][0][m][n], up = acc[ai][1][m][n];
                    if (SCALE) { g = g * r; up = up * r; }
                    float v[4];
#pragma unroll
                    for (int j = 0; j < 4; ++j) v[j] = g[j] * sigmoidf_(g[j]) * up[j];
                    w[2 * n] = cvt_pk_bf16(v[0], v[1]); w[2 * n + 1] = cvt_pk_bf16(v[2], v[3]);
                }
                *(u32x4*)(O + (size_t)row * FF + col0) = (u32x4){w[0], w[1], w[2], w[3]};
            }
    }
};

template <bool BIAS, bool WRITE_XB> struct EpiResid {
    static constexpr bool PERM = false, AFTER_DRAIN = false;
    float* X; bf16_t* XB; float* ssq; const float* bias; float alpha;
    __device__ __forceinline__ void operator()(const f32x4 (&acc)[2][2][4][2], const Unit& u, int wr, int wc, int fr, int fq) const {
        const int row0 = u.pm * BM + wr * 64 + fr, col0 = u.pn * BM + wc * 32 + 4 * fq;
        f32x4 bv[2][2];
#pragma unroll
        for (int bj = 0; bj < 2; ++bj)
#pragma unroll
            for (int n = 0; n < 2; ++n) bv[bj][n] = BIAS ? *(const f32x4*)(bias + col0 + bj * HALF + n * 16) : (f32x4){0.f, 0.f, 0.f, 0.f};
#pragma unroll
        for (int ai = 0; ai < 2; ++ai)
#pragma unroll
            for (int m = 0; m < 4; ++m) {
                const int row = row0 + ai * HALF + m * 16; const size_t off = (size_t)row * D + col0; float s = 0.f;
#pragma unroll
                for (int bj = 0; bj < 2; ++bj)
#pragma unroll
                    for (int n = 0; n < 2; ++n) {
                        f32x4 x = *(const f32x4*)(X + off + bj * HALF + n * 16);
                        x = x + acc[ai][bj][m][n] * alpha + bv[bj][n];
                        *(f32x4*)(X + off + bj * HALF + n * 16) = x;
                        s += (x[0] * x[0] + x[1] * x[1]) + (x[2] * x[2] + x[3] * x[3]);
                        if (WRITE_XB) *(u32x2*)(XB + off + bj * HALF + n * 16) = (u32x2){cvt_pk_bf16(x[0], x[1]), cvt_pk_bf16(x[2], x[3])};
                    }
                s += __shfl_xor(s, 16); s += __shfl_xor(s, 32);
                if (fq == 0) ssq[(size_t)row * 16 + u.pn * 4 + wc] = s;
                asm volatile("" ::: "memory");
            }
    }
};

struct EpiWin {
    static constexpr bool PERM = true, AFTER_DRAIN = false;
    bf16_t* UP; const float* ssq; const float* bin;
    __device__ __forceinline__ void operator()(const f32x4 (&acc)[2][2][4][2], const Unit& u, int wr, int wc, int fr, int fq) const {
        const int row0 = u.pm * BM + wr * 64 + fr, cc0 = wc * 32 + 8 * fq;
        if (u.pn < 4) {
            f32x4 ba[2], bg[2];
#pragma unroll
            for (int n = 0; n < 2; ++n) { ba[n] = *(const f32x4*)(bin + u.pn * HALF + cc0 + 4 * n); bg[n] = *(const f32x4*)(bin + CC + u.pn * HALF + cc0 + 4 * n); }
#pragma unroll
            for (int ai = 0; ai < 2; ++ai)
#pragma unroll
                for (int m = 0; m < 4; ++m) {
                    const int row = row0 + ai * HALF + m * 16; const float r = row_rs(ssq, row, fq);
                    unsigned w[4];
#pragma unroll
                    for (int n = 0; n < 2; ++n) {
                        const f32x4 a = acc[ai][0][m][n] * r + ba[n], g = acc[ai][1][m][n] * r + bg[n];
                        float v[4];
#pragma unroll
                        for (int j = 0; j < 4; ++j) v[j] = a[j] * sigmoidf_(g[j]);
                        w[2 * n] = cvt_pk_bf16(v[0], v[1]); w[2 * n + 1] = cvt_pk_bf16(v[2], v[3]);
                    }
                    *(u32x4*)(UP + (size_t)row * 1024 + u.pn * HALF + cc0) = (u32x4){w[0], w[1], w[2], w[3]};
                }
        } else {
            const int zc0 = 1024 + (u.pn - 4) * BM + cc0, oc0 = CC + (u.pn - 4) * BM + cc0;
            f32x4 bz[2][2];
#pragma unroll
            for (int bj = 0; bj < 2; ++bj)
#pragma unroll
                for (int n = 0; n < 2; ++n) bz[bj][n] = *(const f32x4*)(bin + zc0 + bj * HALF + 4 * n);
#pragma unroll
            for (int ai = 0; ai < 2; ++ai)
#pragma unroll
                for (int m = 0; m < 4; ++m) {
                    const int row = row0 + ai * HALF + m * 16; const float r = row_rs(ssq, row, fq);
#pragma unroll
                    for (int bj = 0; bj < 2; ++bj) {
                        const f32x4 v0 = acc[ai][bj][m][0] * r + bz[bj][0], v1 = acc[ai][bj][m][1] * r + bz[bj][1];
                        *(u32x4*)(UP + (size_t)row * 1024 + oc0 + bj * HALF) = (u32x4){cvt_pk_bf16(v0[0], v0[1]), cvt_pk_bf16(v0[2], v0[3]), cvt_pk_bf16(v1[0], v1[1]), cvt_pk_bf16(v1[2], v1[3])};
                    }
                }
        }
    }
};

template <class Epi, class Sched, bool ALIGN_EPI = false, bool SP2 = false>
__device__ __forceinline__ void gemm_phase(LAS unsigned char* lds, const Gemm g, const Sched& S, const Epi& E) {
    const int tid = threadIdx.x, wid = __builtin_amdgcn_readfirstlane(tid >> 6), lane = tid & 63, wr = wid >> 2, wc = wid & 3, fr = lane & 15, fq = lane >> 4;
    const int K = g.K, nt = K / BK;
    unsigned voffA[2], voffB[2];
#pragma unroll
    for (int i = 0; i < 2; ++i) { int R, C; stage_rc(tid * 16 + i * 8192, R, C); const int Rb = Epi::PERM ? ((R & ~31) + perm32(R & 31)) : R;
        voffA[i] = (unsigned)(R * K + C) * 2u; voffB[i] = (unsigned)(Rb * K + C) * 2u; }
    const size_t kstep = (size_t)(BK * 2);
    const size_t hstep = (size_t)HALF * K * 2;
    const size_t tstep = 2 * hstep;
    const unsigned ldsw = (unsigned)wid * 1024u;
    const int aoff = lds_byte(wr * 64 + fr, fq * 8), boff = lds_byte(wc * 32 + fr, fq * 8);
#define PG8_SA(b, h) (((b) * 2 + (h)) * HTB)
#define PG8_SB(b, h) ((4 + (b) * 2 + (h)) * HTB)
#define PG8_STAGE(bufoff, gbase, voff) do { _Pragma("unroll") for (int _i = 0; _i < 2; ++_i) \
        __builtin_amdgcn_global_load_lds((const unsigned*)((const char*)(gbase) + (voff)[_i]), (LAS unsigned*)(lds + (bufoff) + ldsw + _i * 8192), 16, 0, 0); } while (0)
#define PG8_LDA(dst, b, h) do { _Pragma("unroll") for (int m = 0; m < 4; ++m) _Pragma("unroll") for (int k = 0; k < 2; ++k) dst[m][k] = *(const LAS bf16x8*)(lds + PG8_SA(b, h) + aoff + m * 2048 + k * 1024); } while (0)
#define PG8_LDB(dst, b, h) do { _Pragma("unroll") for (int n = 0; n < 2; ++n) _Pragma("unroll") for (int k = 0; k < 2; ++k) dst[n][k] = *(const LAS bf16x8*)(lds + PG8_SB(b, h) + boff + n * 2048 + k * 1024); } while (0)
#define PG8_MMA(ai, bj, At, Bt) do { __builtin_amdgcn_s_setprio(1); _Pragma("unroll") for (int m = 0; m < 4; ++m) _Pragma("unroll") for (int n = 0; n < 2; ++n) _Pragma("unroll") for (int k = 0; k < 2; ++k) \
        acc[ai][bj][m][n] = __builtin_amdgcn_mfma_f32_16x16x32_bf16(Bt[n][k], At[m][k], acc[ai][bj][m][n], 0, 0, 0); __builtin_amdgcn_s_setprio(0); } while (0)
#define PG8_WAIT_V(n) asm volatile("s_waitcnt vmcnt(" #n ")" ::: "memory")
#define PG8_WAIT_L(n) asm volatile("s_waitcnt lgkmcnt(" #n ")" ::: "memory")
#define PG8_BAR __builtin_amdgcn_s_barrier()
#define PG8_SCHED __builtin_amdgcn_sched_barrier(0)
    Unit cur, nxt; int ui = 0;
    if (!S.next(0, cur)) return;
    f32x4 acc[2][2][4][2];
#pragma unroll
    for (int a = 0; a < 2; ++a)
#pragma unroll
        for (int b = 0; b < 2; ++b)
#pragma unroll
            for (int m = 0; m < 4; ++m)
#pragma unroll
                for (int n = 0; n < 2; ++n) acc[a][b][m][n] = (f32x4){0.f, 0.f, 0.f, 0.f};
    bf16x8 At[4][2], B0[2][2], B1[2][2];
    const char* cA = (const char*)g.A + (size_t)cur.pm * tstep; const char* cB = (const char*)g.Bt + (size_t)cur.pn * tstep;
    S.a_ready(cur);
    if constexpr (SP2) {
        PG8_STAGE(PG8_SB(0, 0), cB, voffB); PG8_STAGE(PG8_SB(0, 1), cB + hstep, voffB); PG8_STAGE(PG8_SA(0, 0), cA, voffA); PG8_STAGE(PG8_SA(0, 1), cA + hstep, voffA);
        if (wr == 1) PG8_BAR;
        PG8_WAIT_V(2); PG8_BAR;
        PG8_STAGE(PG8_SB(1, 0), cB + kstep, voffB); PG8_STAGE(PG8_SA(1, 0), cA + kstep, voffA); PG8_STAGE(PG8_SB(1, 1), cB + hstep + kstep, voffB);
        PG8_WAIT_V(6); PG8_BAR;
    } else {
        PG8_STAGE(PG8_SB(0, 0), cB, voffB); PG8_STAGE(PG8_SA(0, 0), cA, voffA); PG8_STAGE(PG8_SB(0, 1), cB + hstep, voffB); PG8_STAGE(PG8_SA(0, 1), cA + hstep, voffA);
        if (wr == 1) PG8_BAR;
        PG8_WAIT_V(4); PG8_BAR;
        PG8_STAGE(PG8_SB(1, 0), cB + kstep, voffB); PG8_STAGE(PG8_SA(1, 0), cA + kstep, voffA); PG8_STAGE(PG8_SB(1, 1), cB + hstep + kstep, voffB);
        PG8_WAIT_V(6); PG8_BAR;
    }
    for (;;) {
        const bool has_next = S.next(ui + 1, nxt);
        const char* nA = has_next ? (const char*)g.A + (size_t)nxt.pm * tstep : cA; const char* nB = has_next ? (const char*)g.Bt + (size_t)nxt.pn * tstep : cB;
        for (int t = 0; t < nt; t += 2) {
            const bool last = (t == nt - 2);
            const char* a1 = cA + (size_t)(t + 1) * kstep;
            const char* a2 = last ? nA : cA + (size_t)(t + 2) * kstep; const char* b2 = last ? nB : cB + (size_t)(t + 2) * kstep;
            const char* a3 = a2 + kstep; const char* b3 = b2 + kstep;
            if (last && has_next) S.a_ready(nxt);
            if constexpr (SP2) {
            PG8_LDB(B0, 0, 0); PG8_LDB(B1, 0, 1); PG8_SCHED; PG8_LDA(At, 0, 0); PG8_STAGE(PG8_SA(1, 1), a1 + hstep, voffA);
            PG8_WAIT_V(8); PG8_WAIT_L(0); PG8_BAR; PG8_MMA(0, 0, At, B0); PG8_MMA(0, 1, At, B1); PG8_BAR; PG8_SCHED;
            PG8_LDA(At, 0, 1); PG8_STAGE(PG8_SB(0, 0), b2, voffB); PG8_STAGE(PG8_SB(0, 1), b2 + hstep, voffB); PG8_STAGE(PG8_SA(0, 0), a2, voffA);
            PG8_WAIT_V(8); PG8_WAIT_L(0); PG8_BAR; PG8_MMA(1, 0, At, B0); PG8_MMA(1, 1, At, B1); PG8_BAR; PG8_SCHED;
            PG8_LDB(B0, 1, 0); PG8_LDB(B1, 1, 1); PG8_SCHED; PG8_LDA(At, 1, 0); PG8_STAGE(PG8_SA(0, 1), a2 + hstep, voffA);
            PG8_WAIT_V(8); PG8_WAIT_L(0); PG8_BAR; PG8_MMA(0, 0, At, B0); PG8_MMA(0, 1, At, B1); PG8_BAR; PG8_SCHED;
            PG8_LDA(At, 1, 1); PG8_STAGE(PG8_SB(1, 0), b3, voffB); PG8_STAGE(PG8_SB(1, 1), b3 + hstep, voffB); PG8_STAGE(PG8_SA(1, 0), a3, voffA);
            PG8_WAIT_V(8); PG8_WAIT_L(0); PG8_BAR; PG8_MMA(1, 0, At, B0); PG8_MMA(1, 1, At, B1); PG8_BAR; PG8_SCHED;
            } else {
            PG8_LDB(B0, 0, 0); PG8_SCHED; PG8_LDA(At, 0, 0); PG8_STAGE(PG8_SA(1, 1), a1 + hstep, voffA);
            PG8_WAIT_L(8); PG8_BAR; PG8_WAIT_L(0); PG8_MMA(0, 0, At, B0); PG8_BAR; PG8_SCHED;
            PG8_LDB(B1, 0, 1); PG8_STAGE(PG8_SB(0, 0), b2, voffB);
            PG8_BAR; PG8_WAIT_L(0); PG8_MMA(0, 1, At, B1); PG8_BAR;
            PG8_LDA(At, 0, 1); PG8_STAGE(PG8_SA(0, 0), a2, voffA);
            PG8_BAR; PG8_WAIT_L(0); PG8_MMA(1, 0, At, B0); PG8_BAR; PG8_SCHED;
            PG8_STAGE(PG8_SB(0, 1), b2 + hstep, voffB);
            PG8_WAIT_V(6); PG8_BAR; PG8_MMA(1, 1, At, B1); PG8_BAR;
            PG8_LDB(B0, 1, 0); PG8_SCHED; PG8_LDA(At, 1, 0); PG8_STAGE(PG8_SA(0, 1), a2 + hstep, voffA);
            PG8_WAIT_L(8); PG8_BAR; PG8_WAIT_L(0); PG8_MMA(0, 0, At, B0); PG8_BAR; PG8_SCHED;
            PG8_LDB(B1, 1, 1); PG8_STAGE(PG8_SB(1, 0), b3, voffB);
            PG8_BAR; PG8_WAIT_L(0); PG8_MMA(0, 1, At, B1); PG8_BAR;
            PG8_LDA(At, 1, 1); PG8_STAGE(PG8_SA(1, 0), a3, voffA);
            PG8_BAR; PG8_WAIT_L(0); PG8_MMA(1, 0, At, B0); PG8_BAR; PG8_SCHED;
            PG8_STAGE(PG8_SB(1, 1), b3 + hstep, voffB);
            PG8_WAIT_V(6); PG8_BAR; PG8_MMA(1, 1, At, B1); PG8_BAR;
            }
        }
        if constexpr (ALIGN_EPI) { if (wr == 0) PG8_BAR; }
        E(acc, cur, wr, wc, fr, fq); S.done(cur);
        if (!has_next) break;
#pragma unroll
        for (int a = 0; a < 2; ++a)
#pragma unroll
            for (int b = 0; b < 2; ++b)
#pragma unroll
                for (int m = 0; m < 4; ++m)
#pragma unroll
                    for (int n = 0; n < 2; ++n) acc[a][b][m][n] = (f32x4){0.f, 0.f, 0.f, 0.f};
        cur = nxt; cA = nA; cB = nB; ++ui;
        if constexpr (ALIGN_EPI) { if (wr == 1) PG8_BAR; }
    }
    PG8_WAIT_V(0);
    if constexpr (!ALIGN_EPI) { if (wr == 0) PG8_BAR; }
    PG8_BAR;
#undef PG8_SA
#undef PG8_SB
#undef PG8_STAGE
#undef PG8_LDA
#undef PG8_LDB
#undef PG8_MMA
#undef PG8_WAIT_V
#undef PG8_WAIT_L
#undef PG8_BAR
#undef PG8_SCHED
}
}

#ifndef PG8_SP2
#define PG8_SP2 true
#endif
#ifndef PG8_ALIGN
#define PG8_ALIGN true
#endif

constexpr int NWAVES = 8, NTHREADS = NWAVES * 64;
constexpr int RING_BYTES = 131072, LDSCTL_OFF = RING_BYTES, LDS_BYTES = 147456;
constexpr int N_PHASES = 9;

__device__ __forceinline__ unsigned f2bf(float f) { unsigned u = __builtin_bit_cast(unsigned, f); return (u + 0x7fffu + ((u >> 16) & 1u)) >> 16; }
__device__ __forceinline__ unsigned pk2(float lo, float hi) { return f2bf(lo) | (f2bf(hi) << 16); }
__device__ __forceinline__ float bf2f(unsigned short b) { return __builtin_bit_cast(float, (unsigned)b << 16); }
__device__ __forceinline__ float wave_sum(float v) {
#pragma unroll
    for (int o = 1; o < 64; o <<= 1) v += __shfl_xor(v, o);
    return v;
}

#define XB_TMO      128
#define XB_XCNT(j)  (256  + 64 * (j))
#define XB_XSUB(j)  (1280 + 64 * (j))
#define XB_XGEN(j)  (2304 + 64 * (j))
#define XB_TOP      3328
#define XB_TOPGEN   3392
#define XCD_BAR_WORDS 3456
#define XB_SPIN_CAP (1u << 22)
__device__ __forceinline__ unsigned xb_ld(unsigned* p)              { return __hip_atomic_load(p, __ATOMIC_RELAXED, __HIP_MEMORY_SCOPE_AGENT); }
__device__ __forceinline__ unsigned xb_add(unsigned* p, unsigned v) { return __hip_atomic_fetch_add(p, v, __ATOMIC_RELAXED, __HIP_MEMORY_SCOPE_AGENT); }
__device__ __forceinline__ unsigned xb_xcc_id() { return (unsigned)__builtin_amdgcn_s_getreg((3 << 11) | 20) & 0xFu; }
#define XB_SPIN(cond, bar) do { unsigned _sp = 0; while (cond) { __builtin_amdgcn_s_sleep(1); \
    if ((++_sp & 255u) == 0u) { if (xb_ld(&(bar)[XB_TMO])) break; if (_sp > XB_SPIN_CAP) { atomicAdd(&(bar)[XB_TMO], 1u); break; } } } } while (0)
struct XcdBarrier { unsigned* bar; unsigned x; volatile LAS unsigned* st; };
__device__ __forceinline__ XcdBarrier xcd_barrier_post(unsigned* bar, volatile LAS unsigned* st) {
    XcdBarrier b; b.bar = bar; b.x = xb_xcc_id(); b.st = st;
    if (threadIdx.x == 0) (void)xb_add(&bar[XB_XCNT(b.x)], 1u);
    return b;
}
__device__ __forceinline__ void xcd_barrier_complete(unsigned* bar, unsigned x, unsigned& nloc, unsigned& nx) {
    const unsigned G = gridDim.x * gridDim.y * gridDim.z;
    unsigned sum, cnt, mine, sp = 0u;
    for (;;) {
        sum = 0u; cnt = 0u; mine = 0u;
#pragma unroll
        for (unsigned j = 0; j < 16; ++j) { const unsigned c = xb_ld(&bar[XB_XCNT(j)]); sum += c; cnt += (c > 0u) ? 1u : 0u; mine = (j == x) ? c : mine; }
        if (sum == G) break;
        __builtin_amdgcn_s_sleep(1);
        if ((++sp & 255u) == 0u) { if (xb_ld(&bar[XB_TMO])) break; if (sp > XB_SPIN_CAP) { atomicAdd(&bar[XB_TMO], 1u); break; } }
    }
    nloc = mine > 0u ? mine : 1u; nx = cnt > 0u ? cnt : 1u;
}
__device__ __forceinline__ void xcd_barrier(const XcdBarrier& b) {
    asm volatile("s_waitcnt vmcnt(0)" ::: "memory");
    __syncthreads();
    if (threadIdx.x == 0) {
        unsigned* bar = b.bar;
        __builtin_amdgcn_s_waitcnt(0);
        unsigned nloc = b.st[0], nx = b.st[1];
        if (nloc == 0u) { xcd_barrier_complete(bar, b.x, nloc, nx); b.st[0] = nloc; b.st[1] = nx; }
        const unsigned old = xb_add(&bar[XB_XSUB(b.x)], 1u);
        const unsigned gen = old / nloc;
        if (old + 1u == (gen + 1u) * nloc) {
            __builtin_amdgcn_fence(__ATOMIC_RELEASE, "agent");
            asm volatile("s_waitcnt vmcnt(0)" ::: "memory");
            const unsigned og = xb_add(&bar[XB_TOP], 1u);
            const unsigned tg = og / nx;
            if (og + 1u == (tg + 1u) * nx) xb_add(&bar[XB_TOPGEN], 1u);
            else XB_SPIN(xb_ld(&bar[XB_TOPGEN]) == tg, bar);
            __builtin_amdgcn_fence(__ATOMIC_ACQUIRE, "agent");
            xb_add(&bar[XB_XGEN(b.x)], 1u);
            asm volatile("s_waitcnt vmcnt(0)" ::: "memory");
        } else {
            XB_SPIN(xb_ld(&bar[XB_XGEN(b.x)]) == gen, bar);
            __builtin_amdgcn_fence(__ATOMIC_ACQUIRE, "agent");
            asm volatile("s_waitcnt vmcnt(0)" ::: "memory");
        }
    }
    __syncthreads();
}

struct Args {
    const float* in[25];
    float* out; unsigned char* ws;
    int ph_lo, ph_hi, use_cg, pad;
};
enum { I_XP = 0, I_XS, I_SC, I_SP, I_META, I_G1, I_W1G, I_W1U, I_W1D, I_GM, I_WIN, I_BIN, I_WDW, I_BDW, I_LNG, I_LNB, I_WPOOL, I_PSCALE, I_WOUT, I_BOUT, I_G2, I_W2G, I_W2U, I_W2D, I_GF };
constexpr size_t O_YP = 0, O_YS = (size_t)NB * SEQ * D, O_CP = O_YS + (size_t)MSA * D, O_PP = O_CP + (size_t)NB * CH * CC, O_CS = O_PP + (size_t)NB * PH * CPL, O_PS = O_CS + (size_t)NSB * CH * CC, O_END = O_PS + (size_t)NSB * PH * CPL;

__device__ __forceinline__ void transpose_item(const float* W, int K, int N, const float* gain, bf16_t* WT, int dest_row0, int k0, int n0, LAS float* scr, int lane) {
#pragma unroll 8
    for (int i = 0; i < 32; ++i) { const int kk = 2 * i + (lane >> 5); float v = W[(size_t)(k0 + kk) * N + n0 + (lane & 31)]; if (gain) v *= gain[k0 + kk]; scr[kk * 33 + (lane & 31)] = v; }
    asm volatile("s_waitcnt lgkmcnt(0)" ::: "memory");
    const int c = lane & 7;
#pragma unroll
    for (int j = 0; j < 4; ++j) { const int n = (lane >> 3) + 8 * j; const LAS float* s = scr + (8 * c) * 33 + n;
        u32x4 o; o.x = pk2(s[0 * 33], s[1 * 33]); o.y = pk2(s[2 * 33], s[3 * 33]); o.z = pk2(s[4 * 33], s[5 * 33]); o.w = pk2(s[6 * 33], s[7 * 33]);
        *(u32x4*)(WT + (size_t)(dest_row0 + n) * K + k0 + 8 * c) = o; }
    asm volatile("s_waitcnt lgkmcnt(0)" ::: "memory");
}

__device__ __forceinline__ const float* x0_row(const Args& a, int row) {
    if (row < MPR) { const int b = row / TP, t = row - b * TP; return t < NMETA ? a.in[I_META] + (size_t)t * D : a.in[I_XP] + ((size_t)b * SEQ + (t - NMETA)) * D; }
    return a.in[I_XS] + (size_t)(row - MPR) * D;
}

__device__ __forceinline__ void prep_phase(const Args& a, LAS unsigned char* lds, int gw, int NGW, int wave, int lane) {
    unsigned char* ws = a.ws;
    LAS float* scr = (LAS float*)(lds + wave * 16384);
    constexpr int I_FFN_GU = (D / 64) * (FF / 32);
    constexpr int I_FFN_D = (FF / 64) * (D / 32);
    constexpr int I_WIN_ = (D / 64) * (DIN / 32);
    constexpr int I_WOUT_ = (CC / 64) * (D / 32);
    constexpr int NITEMS = 6 * I_FFN_GU + I_WIN_ + I_WOUT_;
    static_assert(I_FFN_GU == I_FFN_D, "items");
    for (int it = gw; it < NITEMS; it += NGW) {
        int r = it;
        if (r < 6 * I_FFN_GU) {
            const int which = r / I_FFN_GU; r -= which * I_FFN_GU;
            const int ffn = which / 3, part = which % 3;
            if (part < 2) {
                const float* W = a.in[(ffn ? I_W2G : I_W1G) + part]; const float* gain = a.in[ffn ? I_G2 : I_G1];
                bf16_t* WT = (bf16_t*)(ws + (ffn ? WS_W2C : WS_W1C));
                const int nblk = FF / 32, kb = r / nblk, nb = r % nblk, n0 = nb * 32;
                const int dest = (n0 / 128) * 256 + part * 128 + (n0 % 128);
                transpose_item(W, D, FF, gain, WT, dest, kb * 64, n0, scr, lane);
            } else {
                const float* W = a.in[ffn ? I_W2D : I_W1D]; bf16_t* WT = (bf16_t*)(ws + (ffn ? WS_W2D : WS_W1D));
                const int nblk = D / 32, kb = r / nblk, nb = r % nblk;
                transpose_item(W, FF, D, nullptr, WT, nb * 32, kb * 64, nb * 32, scr, lane);
            }
            continue;
        }
        r -= 6 * I_FFN_GU;
        if (r < I_WIN_) {
            const int nblk = DIN / 32, kb = r / nblk, nb = r % nblk, n0 = nb * 32;
            int dest;
            if (n0 < CC) dest = (n0 / 128) * 256 + (n0 % 128);
            else if (n0 < 2 * CC) dest = ((n0 - CC) / 128) * 256 + 128 + (n0 % 128);
            else dest = n0;
            transpose_item(a.in[I_WIN], D, DIN, a.in[I_GM], (bf16_t*)(ws + WS_WIN), dest, kb * 64, n0, scr, lane);
            continue;
        }
        r -= I_WIN_;
        { const int nblk = D / 32, kb = r / nblk, nb = r % nblk;
          transpose_item(a.in[I_WOUT], D, D, nullptr, (bf16_t*)(ws + WS_WOUT), nb * 32, kb * 64, nb * 32, scr, lane); }
    }
    {
        const float* wp = a.in[I_WPOOL]; const float* ps = a.in[I_PSCALE]; const float* wo = a.in[I_WOUT]; bf16_t* WT = (bf16_t*)(ws + WS_WOUT);
        for (int it = gw; it < 1024; it += NGW) {
            const int g = it >> 8, cb = (it >> 4) & 15, nb = it & 15, n = nb * 64 + lane;
            float accv[8];
#pragma unroll
            for (int j = 0; j < 8; ++j) accv[j] = 0.f;
            for (int d = 0; d < PG; ++d) {
                const float wv = wo[(size_t)(CC + g * PG + d) * D + n] * ps[g * PG + d];
#pragma unroll
                for (int j = 0; j < 8; ++j) accv[j] += wp[((size_t)g * PG + cb * 8 + j) * PG + d] * wv;
            }
            *(u32x4*)(WT + (size_t)n * D + CC + g * PG + cb * 8) = (u32x4){pk2(accv[0], accv[1]), pk2(accv[2], accv[3]), pk2(accv[4], accv[5]), pk2(accv[6], accv[7])};
        }
    }
    {
        float* X = (float*)(ws + WS_X); bf16_t* XB = (bf16_t*)(ws + WS_XB);
        for (int row = gw; row < MP; row += NGW) {
            f32x4 v[4];
            if (row < M) { const f32x4* xr = (const f32x4*)x0_row(a, row) + lane;
#pragma unroll
                for (int j = 0; j < 4; ++j) v[j] = xr[64 * j]; }
            else {
#pragma unroll
                for (int j = 0; j < 4; ++j) v[j] = (f32x4){0.f, 0.f, 0.f, 0.f}; }
            float s = 0.f;
#pragma unroll
            for (int j = 0; j < 4; ++j) s += (v[j].x * v[j].x + v[j].y * v[j].y) + (v[j].z * v[j].z + v[j].w * v[j].w);
            const float r = __builtin_amdgcn_rsqf(wave_sum(s) * (1.0f / D) + EPS);
            f32x4* xo = (f32x4*)(X + (size_t)row * D) + lane; u32x2* bo = (u32x2*)(XB + (size_t)row * D) + lane;
#pragma unroll
            for (int j = 0; j < 4; ++j) { xo[64 * j] = v[j]; bo[64 * j] = (u32x2){pk2(v[j].x * r, v[j].y * r), pk2(v[j].z * r, v[j].w * r)}; }
        }
    }
}

constexpr int MIX_R = 32;
constexpr int NCH_P = (TP + MIX_R - 1) / MIX_R;
constexpr int N_CHUNKS = NB * NCH_P + NSB;
__device__ __forceinline__ void mixer_phase(const Args& a, LAS unsigned char* lds, int vcu, int G, int tid, int wave, int lane) {
    unsigned char* ws = a.ws;
    const bf16_t* UP = (const bf16_t*)(ws + WS_UP); bf16_t* A4 = (bf16_t*)(ws + WS_A4);
    LAS float* Cb = (LAS float*)lds;
    LAS unsigned short* Db = (LAS unsigned short*)(lds + 65536);
    const int c = tid;
    float w[CW];
#pragma unroll
    for (int k = 0; k < CW; ++k) w[k] = a.in[I_WDW][k * CC + c];
    const float bdw = a.in[I_BDW][c];
    const int pgrp = c >> 7;
    const float* lng = a.in[I_LNG]; const float* lnb = a.in[I_LNB];
    for (int ch = vcu; ch < N_CHUNKS; ch += G) {
        const bool samp = ch >= NB * NCH_P;
        int rowbase, t0, nrows, pos0; const float* hc = nullptr; const float* hp = nullptr;
        if (!samp) { const int b = ch / NCH_P, j = ch - b * NCH_P; t0 = j * MIX_R; nrows = (TP - t0) < MIX_R ? (TP - t0) : MIX_R; rowbase = b * TP; pos0 = t0; }
        else { const int b = ch - NB * NCH_P; t0 = 0; nrows = TS; rowbase = MPR + b * TS; pos0 = PAST_LEN; hc = a.in[I_SC] + (size_t)b * CH * CC; hp = a.in[I_SP] + (size_t)b * PH * CPL; }
        float win[CH + 8], pw[PH + 8];
#pragma unroll
        for (int j = 0; j < CH; ++j) {
            const int t = t0 - CH + j;
            float v = 0.f;
            if (samp) v = hc[j * CC + c];
            else if (t >= 0) v = bf2f(UP[(size_t)(rowbase + t) * 1024 + c]);
            win[j] = v;
        }
#pragma unroll
        for (int j = 0; j < PH; ++j) {
            const int t = t0 - PH + j;
            float v = 0.f;
            if (samp) v = hp[j * CPL + c];
            else if (t >= 0) v = bf2f(UP[(size_t)(rowbase + t) * 1024 + CC + c]);
            pw[j] = v;
        }
        const int ngrp = (nrows + 7) >> 3;
        for (int g = 0; g < ngrp; ++g) {
#pragma unroll
            for (int i = 0; i < 8; ++i) {
                const int t = g * 8 + i; float vu = 0.f, vp = 0.f;
                if (t < nrows) { const bf16_t* rp = UP + (size_t)(rowbase + t0 + t) * 1024; vu = bf2f(rp[c]); vp = bf2f(rp[CC + c]); }
                win[CH + i] = vu; pw[PH + i] = vp;
            }
#pragma unroll
            for (int i = 0; i < 8; ++i) {
                float o = bdw;
#pragma unroll
                for (int k = 0; k < CW; ++k) o += w[k] * win[i + k];
                Cb[(g * 8 + i) * CC + c] = o;
                const float* q = pw + PH + i;
                const float s2 = q[0] + q[-1];
                const float s4 = s2 + (q[-2] + q[-3]);
                const float s8 = s4 + ((q[-4] + q[-5]) + (q[-6] + q[-7]));
                const float s16 = s8 + (((q[-8] + q[-9]) + (q[-10] + q[-11])) + ((q[-12] + q[-13]) + (q[-14] + q[-15])));
                const float ssel = pgrp == 0 ? s2 : (pgrp == 1 ? s4 : (pgrp == 2 ? s8 : s16));
                const int wlen = 2 << pgrp; const int pos = pos0 + g * 8 + i;
                const float cnt = (float)((pos + 1) < wlen ? (pos + 1) : wlen);
                const float dv = ssel / cnt - q[0];
                Db[(g * 8 + i) * CPL + c] = (unsigned short)f2bf(dv);
            }
#pragma unroll
            for (int j = 0; j < CH; ++j) win[j] = win[j + 8];
#pragma unroll
            for (int j = 0; j < PH; ++j) pw[j] = pw[j + 8];
        }
        __syncthreads();
        for (int rr = wave; rr < nrows; rr += NWAVES) {
            const f32x4 v0 = *(const LAS f32x4*)(Cb + rr * CC + 8 * lane), v1 = *(const LAS f32x4*)(Cb + rr * CC + 8 * lane + 4);
            const float mean = wave_sum((v0.x + v0.y) + (v0.z + v0.w) + (v1.x + v1.y) + (v1.z + v1.w)) * (1.0f / CC);
            const f32x4 d0 = v0 - mean, d1 = v1 - mean;
            const float var = wave_sum((d0.x * d0.x + d0.y * d0.y) + (d0.z * d0.z + d0.w * d0.w) + (d1.x * d1.x + d1.y * d1.y) + (d1.z * d1.z + d1.w * d1.w)) * (1.0f / CC);
            const float rstd = __builtin_amdgcn_rsqf(var + EPS);
            const f32x4 g0 = *(const f32x4*)(lng + 8 * lane), g1 = *(const f32x4*)(lng + 8 * lane + 4), b0 = *(const f32x4*)(lnb + 8 * lane), b1 = *(const f32x4*)(lnb + 8 * lane + 4);
            f32x4 y0 = d0 * rstd * g0 + b0, y1 = d1 * rstd * g1 + b1;
#pragma unroll
            for (int j = 0; j < 4; ++j) { y0[j] = y0[j] * pg8::sigmoidf_(y0[j]); y1[j] = y1[j] * pg8::sigmoidf_(y1[j]); }
            bf16_t* orow = A4 + (size_t)(rowbase + t0 + rr) * 1024;
            *(u32x4*)(orow + 8 * lane) = (u32x4){pk2(y0.x, y0.y), pk2(y0.z, y0.w), pk2(y1.x, y1.y), pk2(y1.z, y1.w)};
            *(u32x4*)(orow + CC + 8 * lane) = *(const LAS u32x4*)(Db + rr * CPL + 8 * lane);
        }
        __syncthreads();
    }
    for (int i = vcu * NTHREADS + tid; i < (MP - M) * 1024 / 8; i += G * NTHREADS) *(u32x4*)(A4 + (size_t)M * 1024 + (size_t)i * 8) = (u32x4){0u, 0u, 0u, 0u};
    {
        float* out = a.out;
        const int gt = vcu * NTHREADS + tid, GT = G * NTHREADS;
        for (int i = gt; i < NB * CH * CC; i += GT) { const int cch = i % CC, j = (i / CC) % CH, b = i / (CC * CH); out[O_CP + i] = bf2f(UP[(size_t)(b * TP + TP - CH + j) * 1024 + cch]); }
        for (int i = gt; i < NB * PH * CPL; i += GT) { const int cch = i % CPL, j = (i / CPL) % PH, b = i / (CPL * PH); out[O_PP + i] = bf2f(UP[(size_t)(b * TP + TP - PH + j) * 1024 + CC + cch]); }
        for (int i = gt; i < NSB * CH * CC; i += GT) { const int cch = i % CC, j = (i / CC) % CH, b = i / (CC * CH);
            out[O_CS + i] = (j < CH - TS) ? a.in[I_SC][((size_t)b * CH + j + TS) * CC + cch] : bf2f(UP[(size_t)(MPR + b * TS + (j - (CH - TS))) * 1024 + cch]); }
        for (int i = gt; i < NSB * PH * CPL; i += GT) { const int cch = i % CPL, j = (i / CPL) % PH, b = i / (CPL * PH);
            out[O_PS + i] = (j < PH - TS) ? a.in[I_SP][((size_t)b * PH + j + TS) * CPL + cch] : bf2f(UP[(size_t)(MPR + b * TS + (j - (PH - TS))) * 1024 + CC + cch]); }
    }
}

__device__ __forceinline__ void final_phase(const Args& a, int gw, int NGW, int lane) {
    const float* X = (const float*)(a.ws + WS_X); const float* ssq = (const float*)(a.ws + WS_SSQ3); const float* gf = a.in[I_GF];
    f32x4 gv[4];
#pragma unroll
    for (int j = 0; j < 4; ++j) gv[j] = *((const f32x4*)gf + lane + 64 * j);
    constexpr int NOUT = NB * SEQ + MSA;
    for (int o = gw; o < NOUT; o += NGW) {
        int row; float* dst;
        if (o < NB * SEQ) { const int b = o / SEQ, t = o - b * SEQ; row = b * TP + NMETA + t; dst = a.out + O_YP + (size_t)o * D; }
        else { row = MPR + (o - NB * SEQ); dst = a.out + O_YS + (size_t)(o - NB * SEQ) * D; }
        const f32x4* sp = (const f32x4*)(ssq + (size_t)row * 16);
        const f32x4 p0 = sp[0], p1 = sp[1], p2 = sp[2], p3 = sp[3];
        const float s = (((p0.x + p0.y) + (p0.z + p0.w)) + ((p1.x + p1.y) + (p1.z + p1.w))) + (((p2.x + p2.y) + (p2.z + p2.w)) + ((p3.x + p3.y) + (p3.z + p3.w)));
        const float r = __builtin_amdgcn_rsqf(s * (1.0f / D) + EPS);
        const f32x4* xr = (const f32x4*)(X + (size_t)row * D) + lane; f32x4* yo = (f32x4*)dst + lane;
#pragma unroll
        for (int j = 0; j < 4; ++j) yo[64 * j] = xr[64 * j] * r * gv[j];
    }
}

__global__ void __launch_bounds__(NTHREADS, 2) mk_fwd(Args args) {
    extern __shared__ __attribute__((aligned(16))) unsigned char lds_raw[];
    LAS unsigned char* lds = (LAS unsigned char*)lds_raw;
    volatile LAS unsigned* MISC = (volatile LAS unsigned*)(lds + LDSCTL_OFF);
    const int tid = threadIdx.x, lane = tid & 63, wave = __builtin_amdgcn_readfirstlane(tid >> 6);
    const int G = gridDim.x; const int bx = blockIdx.x; const int vcu = (G % 8 == 0) ? (bx % 8) * (G / 8) + bx / 8 : bx;
    const int gw = vcu * NWAVES + wave, NGW = G * NWAVES;
    unsigned char* ws = args.ws;
    if (tid < 64) MISC[tid] = 0u;
    __syncthreads();
    XcdBarrier bar; bar.bar = (unsigned*)(ws + WS_CTL) + 1024; bar.x = 0; bar.st = nullptr;
    if (MK_N_LAUNCHES == 1) bar = xcd_barrier_post((unsigned*)(ws + WS_CTL) + 1024, MISC + 8);
    const int lo = args.ph_lo, hi = args.ph_hi;
#define IN(k) (lo <= (k) && (k) < hi)
#define BOTH(k) (IN(k) && IN((k) + 1))
#define GRID_BAR() do { if (args.use_cg) { cg::this_grid().sync(); } else { xcd_barrier(bar); } } while (0)

    bf16_t* XB = (bf16_t*)(ws + WS_XB); float* X = (float*)(ws + WS_X); bf16_t* R1 = (bf16_t*)(ws + WS_R1);
    float* SSQ1 = (float*)(ws + WS_SSQ1); float* SSQ2 = (float*)(ws + WS_SSQ2); float* SSQ3 = (float*)(ws + WS_SSQ3);

    if (IN(0)) { prep_phase(args, lds, gw, NGW, wave, lane); if (BOTH(0)) { cg::this_grid().sync(); } }

    if (IN(1)) {
        pg8::Gemm g{XB, (const bf16_t*)(ws + WS_W1C), MP, 2 * FF, D}; pg8::StaticOrder S; S.init(MP, 2 * FF, G, bx);
        pg8::EpiSwiglu<false> E{R1, nullptr};
        pg8::gemm_phase<pg8::EpiSwiglu<false>, pg8::StaticOrder, PG8_ALIGN, PG8_SP2>(lds, g, S, E);
        if (BOTH(1)) GRID_BAR();
    }
    if (IN(2)) {
        pg8::Gemm g{R1, (const bf16_t*)(ws + WS_W1D), MP, D, FF}; pg8::StaticOrder S; S.init(MP, D, G, bx);
        pg8::EpiResid<false, true> E{X, XB, SSQ1, nullptr, 0.5f};
        pg8::gemm_phase<pg8::EpiResid<false, true>, pg8::StaticOrder, PG8_ALIGN, PG8_SP2>(lds, g, S, E);
        if (BOTH(2)) GRID_BAR();
    }
    if (IN(3)) {
        pg8::Gemm g{XB, (const bf16_t*)(ws + WS_WIN), MP, DIN, D}; pg8::StaticOrder S; S.init(MP, DIN, G, bx);
        pg8::EpiWin E{(bf16_t*)(ws + WS_UP), SSQ1, args.in[I_BIN]};
        pg8::gemm_phase<pg8::EpiWin, pg8::StaticOrder, PG8_ALIGN, PG8_SP2>(lds, g, S, E);
        if (BOTH(3)) GRID_BAR();
    }
    if (IN(4)) { mixer_phase(args, lds, vcu, G, tid, wave, lane); if (BOTH(4)) GRID_BAR(); }
    if (IN(5)) {
        pg8::Gemm g{(const bf16_t*)(ws + WS_A4), (const bf16_t*)(ws + WS_WOUT), MP, D, D}; pg8::StaticOrder S; S.init(MP, D, G, bx);
        pg8::EpiResid<true, true> E{X, XB, SSQ2, args.in[I_BOUT], 1.0f};
        pg8::gemm_phase<pg8::EpiResid<true, true>, pg8::StaticOrder, PG8_ALIGN, PG8_SP2>(lds, g, S, E);
        if (BOTH(5)) GRID_BAR();
    }
    if (IN(6)) {
        pg8::Gemm g{XB, (const bf16_t*)(ws + WS_W2C), MP, 2 * FF, D}; pg8::StaticOrder S; S.init(MP, 2 * FF, G, bx);
        pg8::EpiSwiglu<true> E{R1, SSQ2};
        pg8::gemm_phase<pg8::EpiSwiglu<true>, pg8::StaticOrder, PG8_ALIGN, PG8_SP2>(lds, g, S, E);
        if (BOTH(6)) GRID_BAR();
    }
    if (IN(7)) {
        pg8::Gemm g{R1, (const bf16_t*)(ws + WS_W2D), MP, D, FF}; pg8::StaticOrder S; S.init(MP, D, G, bx);
        pg8::EpiResid<false, false> E{X, nullptr, SSQ3, nullptr, 0.5f};
        pg8::gemm_phase<pg8::EpiResid<false, false>, pg8::StaticOrder, PG8_ALIGN, PG8_SP2>(lds, g, S, E);
        if (BOTH(7)) GRID_BAR();
    }
    if (IN(8)) final_phase(args, gw, NGW, lane);
#undef IN
#undef BOTH
#undef GRID_BAR
}

extern "C" void kernel_launch(void* const* d_in, const int* in_sizes, int n_in, void* d_out, int out_size, void* d_ws, size_t ws_size, hipStream_t stream) {
    static int grid = 0;
    if (grid == 0) {
        if (n_in != 25 || (size_t)out_size != O_END || ws_size < WS_END) { fprintf(stderr, "kernel_launch: unexpected shapes (n_in %d out %d ws %zu)\n", n_in, out_size, ws_size); grid = -1; return; }
        int dev = 0, cus = 0, per_cu = 0;
        if (hipGetDevice(&dev) != hipSuccess || hipDeviceGetAttribute(&cus, hipDeviceAttributeMultiprocessorCount, dev) != hipSuccess) { grid = -1; return; }
        if (hipFuncSetAttribute((const void*)mk_fwd, hipFuncAttributeMaxDynamicSharedMemorySize, LDS_BYTES) != hipSuccess) { fprintf(stderr, "kernel_launch: hipFuncSetAttribute failed\n"); grid = -1; return; }
        if (hipOccupancyMaxActiveBlocksPerMultiprocessor(&per_cu, (const void*)mk_fwd, NTHREADS, LDS_BYTES) != hipSuccess || per_cu < 1) { fprintf(stderr, "kernel_launch: occupancy query says %d\n", per_cu); per_cu = 1; }
        (void)hipGetLastError();
        grid = cus * 1;
    }
    if (grid < 0) return;
    (void)hipMemsetAsync((char*)d_ws + WS_CTL, 0, CTL_ZERO_BYTES, stream);
    Args a{};
    for (int i = 0; i < 25; ++i) a.in[i] = (const float*)d_in[i];
    a.out = (float*)d_out; a.ws = (unsigned char*)d_ws;
    if (MK_N_LAUNCHES == 1) {
        a.ph_lo = 0; a.ph_hi = N_PHASES; a.use_cg = 0;
        void* kargs[] = {&a};
        hipError_t e = hipLaunchCooperativeKernel((const void*)mk_fwd, dim3(grid), dim3(NTHREADS), kargs, LDS_BYTES, stream);
        if (e != hipSuccess) fprintf(stderr, "kernel_launch: cooperative launch failed: %s (grid %d)\n", hipGetErrorString(e), grid);
    } else {
        for (int p = 0; p < N_PHASES; ++p) {
            a.ph_lo = p; a.ph_hi = p + 1; a.use_cg = 0;
            hipLaunchKernelGGL(mk_fwd, dim3(grid), dim3(NTHREADS), LDS_BYTES, stream, a);
        }
    }
}
```

```cpp
#include <hip/hip_runtime.h>
#include <hip/hip_cooperative_groups.h>
#include <cstdio>
#include <cstdint>
namespace cg = cooperative_groups;

#ifndef MK_N_LAUNCHES
#define MK_N_LAUNCHES 1
#endif

#define LAS __attribute__((address_space(3)))
typedef unsigned short bf16_t;
typedef short bf16x8 __attribute__((ext_vector_type(8)));
typedef float f32x4 __attribute__((ext_vector_type(4)));
typedef unsigned u32x4 __attribute__((ext_vector_type(4)));
typedef unsigned u32x2 __attribute__((ext_vector_type(2)));

constexpr int D = 1024, FF = 2816, NB = 8, NMETA = 16, SEQ = 2048, TP = NMETA + SEQ  , MPR = NB * TP  ;
constexpr int NSB = 128, TS = 4, MSA = NSB * TS  , M = MPR + MSA  , MP = 17152  ;
constexpr int CC = 512, CPL = 512, DIN = 1536, CW = 31, CH = 30, PH = 15, PG = 128;
constexpr float EPS = 1e-6f;
constexpr int PAST_LEN = 16384;

constexpr size_t MiB = 1u << 20;
constexpr size_t WS_CTL = 0, CTL_ZERO_BYTES = 64 * 1024;
constexpr size_t WS_SSQ1 = 1 * MiB, WS_SSQ2 = 1 * MiB + 1280 * 1024, WS_SSQ3 = 1 * MiB + 2560 * 1024;
constexpr size_t WS_W1C = 6 * MiB, WS_W1D = 17 * MiB, WS_WIN = 22 * MiB + 512 * 1024, WS_WOUT = 25 * MiB + 512 * 1024, WS_W2C = 27 * MiB + 512 * 1024, WS_W2D = 38 * MiB + 512 * 1024;
constexpr size_t WS_XB = 44 * MiB;
constexpr size_t WS_X = 78 * MiB;
constexpr size_t WS_R1 = 145 * MiB;
constexpr size_t WS_UP = WS_R1, WS_A4 = WS_R1 + 34 * MiB;
constexpr size_t WS_END = WS_R1 + (size_t)MP * FF * 2;
static_assert(WS_END <= 256 * MiB, "ws map");
static_assert(WS_SSQ3 + (size_t)MP * 64 <= WS_W1C && WS_XB + (size_t)MP * D * 2 <= WS_X && WS_X + (size_t)MP * D * 4 <= WS_R1 && WS_A4 + (size_t)MP * D * 2 <= WS_END, "ws map 2");

namespace pg8 {
constexpr int BM = 256, BK = 64, HALF = 128, HTB = HALF * BK * 2, STAGE_BYTES = 8 * HTB, NXCD = 8, WGM = 8;
__host__ __device__ __forceinline__ int lds_byte(int r, int c) { const int st = (r >> 4) * 2 + (c >> 5), rr = r & 15, cc = c & 31, ob = rr * 64 + cc * 2; return st * 1024 + (ob ^ (((ob >> 9) & 1) << 5)); }
__host__ __device__ __forceinline__ void stage_rc(int b, int& R, int& C) { const int st = b / 1024, sb = b % 1024, swz = sb ^ (((sb >> 9) & 1) << 5); R = (st >> 1) * 16 + swz / 64; C = (st & 1) * 32 + (swz % 64) / 2; }
__host__ __device__ __forceinline__ int perm32(int rho) { const int n = rho >> 4, i = rho & 15; return 8 * (i >> 2) + 4 * n + (i & 3); }

struct Unit { int pm, pn; };
struct Gemm { const bf16_t* A; const bf16_t* Bt; int M, N, K; };

struct StaticOrder {
    int nM, nN, nwg, G, c;
    __device__ void init(int M_, int N_, int G_, int c_) { nM = M_ / BM; nN = N_ / BM; nwg = nM * nN; G = G_; c = c_; }
    __device__ bool next(int i, Unit& u) const {
        const long L = (long)i * G + c; if (L >= nwg) return false;
        int wgid = (int)L; { const int q = nwg / NXCD, r = nwg % NXCD, xcd = wgid % NXCD, off = wgid / NXCD; wgid = (xcd < r ? xcd * (q + 1) : r * (q + 1) + (xcd - r) * q) + off; }
        const int nig = WGM * nN, gid = wgid / nig, fm = gid * WGM, gsz = (nM - fm) < WGM ? (nM - fm) : WGM;
        u.pm = fm + ((wgid % nig) % gsz); u.pn = (wgid % nig) / gsz; return true;
    }
    __device__ __forceinline__ void a_ready(const Unit&) const {}
    __device__ __forceinline__ void done(const Unit&) const {}
};

__device__ __forceinline__ unsigned cvt_pk_bf16(float lo, float hi) { unsigned r; asm volatile("v_cvt_pk_bf16_f32 %0, %1, %2" : "=v"(r) : "v"(lo), "v"(hi)); return r; }
__device__ __forceinline__ float sigmoidf_(float x) { return __builtin_amdgcn_rcpf(1.0f + __builtin_amdgcn_exp2f(-1.44269504089f * x)); }

__device__ __forceinline__ float row_rs(const float* ssq, int row, int fq) {
    const f32x4 p = *(const f32x4*)(ssq + (size_t)row * 16 + 4 * fq);
    float s = (p.x + p.y) + (p.z + p.w);
    s += __shfl_xor(s, 16); s += __shfl_xor(s, 32);
    return __builtin_amdgcn_rsqf(s * (1.0f / D) + EPS);
}


template <bool SCALE> struct EpiSwiglu {
    static constexpr bool PERM = true, AFTER_DRAIN = false;
    bf16_t* O; const float* ssq;
    __device__ __forceinline__ void operator()(const f32x4 (&acc)[2][2][4][2], const Unit& u, int wr, int wc, int fr, int fq) const {
        const int row0 = u.pm * BM + wr * 64 + fr, col0 = u.pn * HALF + wc * 32 + 8 * fq;
#pragma unroll
        for (int ai = 0; ai < 2; ++ai)
#pragma unroll
            for (int m = 0; m < 4; ++m) {
                const int row = row0 + ai * HALF + m * 16;
                float r = 1.0f; if (SCALE) r = row_rs(ssq, row, fq);
                unsigned w[4];
#pragma unroll
                for (int n = 0; n < 2; ++n) {
                    f32x4 g = acc[ai][0][m][n], up = acc[ai][1][m][n];
                    if (SCALE) { g = g * r; up = up * r; }
                    float v[4];
#pragma unroll
                    for (int j = 0; j < 4; ++j) v[j] = g[j] * sigmoidf_(g[j]) * up[j];
                    w[2 * n] = cvt_pk_bf16(v[0], v[1]); w[2 * n + 1] = cvt_pk_bf16(v[2], v[3]);
                }
                *(u32x4*)(O + (size_t)row * FF + col0) = (u32x4){w[0], w[1], w[2], w[3]};
            }
    }
};

template <bool BIAS, bool WRITE_XB, bool SRC0 = false> struct EpiResid {
    static constexpr bool PERM = false, AFTER_DRAIN = false;
    float* X; bf16_t* XB; float* ssq; const float* bias; float alpha; const float* xp; const float* xs; const float* meta;
    __device__ __forceinline__ void operator()(const f32x4 (&acc)[2][2][4][2], const Unit& u, int wr, int wc, int fr, int fq) const {
        const int row0 = u.pm * BM + wr * 64 + fr, col0 = u.pn * BM + wc * 32 + 4 * fq;
        f32x4 bv[2][2];
#pragma unroll
        for (int bj = 0; bj < 2; ++bj)
#pragma unroll
            for (int n = 0; n < 2; ++n) bv[bj][n] = BIAS ? *(const f32x4*)(bias + col0 + bj * HALF + n * 16) : (f32x4){0.f, 0.f, 0.f, 0.f};
#pragma unroll
        for (int ai = 0; ai < 2; ++ai)
#pragma unroll
            for (int m = 0; m < 4; ++m) {
                const int row = row0 + ai * HALF + m * 16; const size_t off = (size_t)row * D + col0; float s = 0.f;
                const float* srow = X + off;
                if (SRC0) { if (row < MPR) { const int b = row / TP, t = row - b * TP; srow = (t < NMETA ? meta + (size_t)t * D : xp + ((size_t)b * SEQ + (t - NMETA)) * D) + col0; }
                            else srow = xs + (size_t)((row < M ? row : M - 1) - MPR) * D + col0; }
#pragma unroll
                for (int bj = 0; bj < 2; ++bj)
#pragma unroll
                    for (int n = 0; n < 2; ++n) {
                        f32x4 x = *(const f32x4*)(srow + bj * HALF + n * 16);
                        if (SRC0 && row >= M) x = (f32x4){0.f, 0.f, 0.f, 0.f};
                        x = x + acc[ai][bj][m][n] * alpha + bv[bj][n];
                        *(f32x4*)(X + off + bj * HALF + n * 16) = x;
                        s += (x[0] * x[0] + x[1] * x[1]) + (x[2] * x[2] + x[3] * x[3]);
                        if (WRITE_XB) *(u32x2*)(XB + off + bj * HALF + n * 16) = (u32x2){cvt_pk_bf16(x[0], x[1]), cvt_pk_bf16(x[2], x[3])};
                    }
                s += __shfl_xor(s, 16); s += __shfl_xor(s, 32);
                if (fq == 0) ssq[(size_t)row * 16 + u.pn * 4 + wc] = s;
                asm volatile("" ::: "memory");
            }
    }
};

struct EpiWin {
    static constexpr bool PERM = true, AFTER_DRAIN = false;
    bf16_t* UP; const float* ssq; const float* bin;
    __device__ __forceinline__ void operator()(const f32x4 (&acc)[2][2][4][2], const Unit& u, int wr, int wc, int fr, int fq) const {
        const int row0 = u.pm * BM + wr * 64 + fr, cc0 = wc * 32 + 8 * fq;
        if (u.pn < 4) {
            f32x4 ba[2], bg[2];
#pragma unroll
            for (int n = 0; n < 2; ++n) { ba[n] = *(const f32x4*)(bin + u.pn * HALF + cc0 + 4 * n); bg[n] = *(const f32x4*)(bin + CC + u.pn * HALF + cc0 + 4 * n); }
#pragma unroll
            for (int ai = 0; ai < 2; ++ai)
#pragma unroll
                for (int m = 0; m < 4; ++m) {
                    const int row = row0 + ai * HALF + m * 16; const float r = row_rs(ssq, row, fq);
                    unsigned w[4];
#pragma unroll
                    for (int n = 0; n < 2; ++n) {
                        const f32x4 a = acc[ai][0][m][n] * r + ba[n], g = acc[ai][1][m][n] * r + bg[n];
                        float v[4];
#pragma unroll
                        for (int j = 0; j < 4; ++j) v[j] = a[j] * sigmoidf_(g[j]);
                        w[2 * n] = cvt_pk_bf16(v[0], v[1]); w[2 * n + 1] = cvt_pk_bf16(v[2], v[3]);
                    }
                    *(u32x4*)(UP + (size_t)row * 1024 + u.pn * HALF + cc0) = (u32x4){w[0], w[1], w[2], w[3]};
                }
        } else {
            const int zc0 = 1024 + (u.pn - 4) * BM + cc0, oc0 = CC + (u.pn - 4) * BM + cc0;
            f32x4 bz[2][2];
#pragma unroll
            for (int bj = 0; bj < 2; ++bj)
#pragma unroll
                for (int n = 0; n < 2; ++n) bz[bj][n] = *(const f32x4*)(bin + zc0 + bj * HALF + 4 * n);
#pragma unroll
            for (int ai = 0; ai < 2; ++ai)
#pragma unroll
                for (int m = 0; m < 4; ++m) {
                    const int row = row0 + ai * HALF + m * 16; const float r = row_rs(ssq, row, fq);
#pragma unroll
                    for (int bj = 0; bj < 2; ++bj) {
                        const f32x4 v0 = acc[ai][bj][m][0] * r + bz[bj][0], v1 = acc[ai][bj][m][1] * r + bz[bj][1];
                        *(u32x4*)(UP + (size_t)row * 1024 + oc0 + bj * HALF) = (u32x4){cvt_pk_bf16(v0[0], v0[1]), cvt_pk_bf16(v0[2], v0[3]), cvt_pk_bf16(v1[0], v1[1]), cvt_pk_bf16(v1[2], v1[3])};
                    }
                }
        }
    }
};

template <class Epi, class Sched, bool ALIGN_EPI = false, bool SP2 = false>
__device__ __forceinline__ void gemm_phase(LAS unsigned char* lds, const Gemm g, const Sched& S, const Epi& E) {
    const int tid = threadIdx.x, wid = __builtin_amdgcn_readfirstlane(tid >> 6), lane = tid & 63, wr = wid >> 2, wc = wid & 3, fr = lane & 15, fq = lane >> 4;
    const int K = g.K, nt = K / BK;
    unsigned voffA[2], voffB[2];
#pragma unroll
    for (int i = 0; i < 2; ++i) { int R, C; stage_rc(tid * 16 + i * 8192, R, C); const int Rb = Epi::PERM ? ((R & ~31) + perm32(R & 31)) : R;
        voffA[i] = (unsigned)(R * K + C) * 2u; voffB[i] = (unsigned)(Rb * K + C) * 2u; }
    const size_t kstep = (size_t)(BK * 2);
    const size_t hstep = (size_t)HALF * K * 2;
    const size_t tstep = 2 * hstep;
    const unsigned ldsw = (unsigned)wid * 1024u;
    const int aoff = lds_byte(wr * 64 + fr, fq * 8), boff = lds_byte(wc * 32 + fr, fq * 8);
#define PG8_SA(b, h) (((b) * 2 + (h)) * HTB)
#define PG8_SB(b, h) ((4 + (b) * 2 + (h)) * HTB)
#define PG8_STAGE(bufoff, gbase, voff) do { _Pragma("unroll") for (int _i = 0; _i < 2; ++_i) \
        __builtin_amdgcn_global_load_lds((const unsigned*)((const char*)(gbase) + (voff)[_i]), (LAS unsigned*)(lds + (bufoff) + ldsw + _i * 8192), 16, 0, 0); } while (0)
#define PG8_LDA(dst, b, h) do { _Pragma("unroll") for (int m = 0; m < 4; ++m) _Pragma("unroll") for (int k = 0; k < 2; ++k) dst[m][k] = *(const LAS bf16x8*)(lds + PG8_SA(b, h) + aoff + m * 2048 + k * 1024); } while (0)
#define PG8_LDB(dst, b, h) do { _Pragma("unroll") for (int n = 0; n < 2; ++n) _Pragma("unroll") for (int k = 0; k < 2; ++k) dst[n][k] = *(const LAS bf16x8*)(lds + PG8_SB(b, h) + boff + n * 2048 + k * 1024); } while (0)
#define PG8_MMA(ai, bj, At, Bt) do { __builtin_amdgcn_s_setprio(1); _Pragma("unroll") for (int m = 0; m < 4; ++m) _Pragma("unroll") for (int n = 0; n < 2; ++n) _Pragma("unroll") for (int k = 0; k < 2; ++k) \
        acc[ai][bj][m][n] = __builtin_amdgcn_mfma_f32_16x16x32_bf16(Bt[n][k], At[m][k], acc[ai][bj][m][n], 0, 0, 0); __builtin_amdgcn_s_setprio(0); } while (0)
#define PG8_WAIT_V(n) asm volatile("s_waitcnt vmcnt(" #n ")" ::: "memory")
#define PG8_WAIT_L(n) asm volatile("s_waitcnt lgkmcnt(" #n ")" ::: "memory")
#define PG8_BAR __builtin_amdgcn_s_barrier()
#define PG8_SCHED __builtin_amdgcn_sched_barrier(0)
    Unit cur, nxt; int ui = 0;
    if (!S.next(0, cur)) return;
    f32x4 acc[2][2][4][2];
#pragma unroll
    for (int a = 0; a < 2; ++a)
#pragma unroll
        for (int b = 0; b < 2; ++b)
#pragma unroll
            for (int m = 0; m < 4; ++m)
#pragma unroll
                for (int n = 0; n < 2; ++n) acc[a][b][m][n] = (f32x4){0.f, 0.f, 0.f, 0.f};
    bf16x8 At[4][2], B0[2][2], B1[2][2];
    const char* cA = (const char*)g.A + (size_t)cur.pm * tstep; const char* cB = (const char*)g.Bt + (size_t)cur.pn * tstep;
    S.a_ready(cur);
    if constexpr (SP2) {
        PG8_STAGE(PG8_SB(0, 0), cB, voffB); PG8_STAGE(PG8_SB(0, 1), cB + hstep, voffB); PG8_STAGE(PG8_SA(0, 0), cA, voffA); PG8_STAGE(PG8_SA(0, 1), cA + hstep, voffA);
        if (wr == 1) PG8_BAR;
        PG8_WAIT_V(2); PG8_BAR;
        PG8_STAGE(PG8_SB(1, 0), cB + kstep, voffB); PG8_STAGE(PG8_SA(1, 0), cA + kstep, voffA); PG8_STAGE(PG8_SB(1, 1), cB + hstep + kstep, voffB);
        PG8_WAIT_V(6); PG8_BAR;
    } else {
        PG8_STAGE(PG8_SB(0, 0), cB, voffB); PG8_STAGE(PG8_SA(0, 0), cA, voffA); PG8_STAGE(PG8_SB(0, 1), cB + hstep, voffB); PG8_STAGE(PG8_SA(0, 1), cA + hstep, voffA);
        if (wr == 1) PG8_BAR;
        PG8_WAIT_V(4); PG8_BAR;
        PG8_STAGE(PG8_SB(1, 0), cB + kstep, voffB); PG8_STAGE(PG8_SA(1, 0), cA + kstep, voffA); PG8_STAGE(PG8_SB(1, 1), cB + hstep + kstep, voffB);
        PG8_WAIT_V(6); PG8_BAR;
    }
    for (;;) {
        const bool has_next = S.next(ui + 1, nxt);
        const char* nA = has_next ? (const char*)g.A + (size_t)nxt.pm * tstep : cA; const char* nB = has_next ? (const char*)g.Bt + (size_t)nxt.pn * tstep : cB;
        for (int t = 0; t < nt; t += 2) {
            const bool last = (t == nt - 2);
            const char* a1 = cA + (size_t)(t + 1) * kstep;
            const char* a2 = last ? nA : cA + (size_t)(t + 2) * kstep; const char* b2 = last ? nB : cB + (size_t)(t + 2) * kstep;
            const char* a3 = a2 + kstep; const char* b3 = b2 + kstep;
            if (last && has_next) S.a_ready(nxt);
            if constexpr (SP2) {
            PG8_LDB(B0, 0, 0); PG8_LDB(B1, 0, 1); PG8_SCHED; PG8_LDA(At, 0, 0); PG8_STAGE(PG8_SA(1, 1), a1 + hstep, voffA);
            PG8_WAIT_V(8); PG8_WAIT_L(0); PG8_BAR; PG8_MMA(0, 0, At, B0); PG8_MMA(0, 1, At, B1); PG8_BAR; PG8_SCHED;
            PG8_LDA(At, 0, 1); PG8_STAGE(PG8_SB(0, 0), b2, voffB); PG8_STAGE(PG8_SB(0, 1), b2 + hstep, voffB); PG8_STAGE(PG8_SA(0, 0), a2, voffA);
            PG8_WAIT_V(8); PG8_WAIT_L(0); PG8_BAR; PG8_MMA(1, 0, At, B0); PG8_MMA(1, 1, At, B1); PG8_BAR; PG8_SCHED;
            PG8_LDB(B0, 1, 0); PG8_LDB(B1, 1, 1); PG8_SCHED; PG8_LDA(At, 1, 0); PG8_STAGE(PG8_SA(0, 1), a2 + hstep, voffA);
            PG8_WAIT_V(8); PG8_WAIT_L(0); PG8_BAR; PG8_MMA(0, 0, At, B0); PG8_MMA(0, 1, At, B1); PG8_BAR; PG8_SCHED;
            PG8_LDA(At, 1, 1); PG8_STAGE(PG8_SB(1, 0), b3, voffB); PG8_STAGE(PG8_SB(1, 1), b3 + hstep, voffB); PG8_STAGE(PG8_SA(1, 0), a3, voffA);
            PG8_WAIT_V(8); PG8_WAIT_L(0); PG8_BAR; PG8_MMA(1, 0, At, B0); PG8_MMA(1, 1, At, B1); PG8_BAR; PG8_SCHED;
            } else {
            PG8_LDB(B0, 0, 0); PG8_SCHED; PG8_LDA(At, 0, 0); PG8_STAGE(PG8_SA(1, 1), a1 + hstep, voffA);
            PG8_WAIT_L(8); PG8_BAR; PG8_WAIT_L(0); PG8_MMA(0, 0, At, B0); PG8_BAR; PG8_SCHED;
            PG8_LDB(B1, 0, 1); PG8_STAGE(PG8_SB(0, 0), b2, voffB);
            PG8_BAR; PG8_WAIT_L(0); PG8_MMA(0, 1, At, B1); PG8_BAR;
            PG8_LDA(At, 0, 1); PG8_STAGE(PG8_SA(0, 0), a2, voffA);
            PG8_BAR; PG8_WAIT_L(0); PG8_MMA(1, 0, At, B0); PG8_BAR; PG8_SCHED;
            PG8_STAGE(PG8_SB(0, 1), b2 + hstep, voffB);
            PG8_WAIT_V(6); PG8_BAR; PG8_MMA(1, 1, At, B1); PG8_BAR;
            PG8_LDB(B0, 1, 0); PG8_SCHED; PG8_LDA(At, 1, 0); PG8_STAGE(PG8_SA(0, 1), a2 + hstep, voffA);
            PG8_WAIT_L(8); PG8_BAR; PG8_WAIT_L(0); PG8_MMA(0, 0, At, B0); PG8_BAR; PG8_SCHED;
            PG8_LDB(B1, 1, 1); PG8_STAGE(PG8_SB(1, 0), b3, voffB);
            PG8_BAR; PG8_WAIT_L(0); PG8_MMA(0, 1, At, B1); PG8_BAR;
            PG8_LDA(At, 1, 1); PG8_STAGE(PG8_SA(1, 0), a3, voffA);
            PG8_BAR; PG8_WAIT_L(0); PG8_MMA(1, 0, At, B0); PG8_BAR; PG8_SCHED;
            PG8_STAGE(PG8_SB(1, 1), b3 + hstep, voffB);
            PG8_WAIT_V(6); PG8_BAR; PG8_MMA(1, 1, At, B1); PG8_BAR;
            }
        }
        if constexpr (ALIGN_EPI) { if (wr == 0) PG8_BAR; }
        E(acc, cur, wr, wc, fr, fq); S.done(cur);
        if (!has_next) break;
#pragma unroll
        for (int a = 0; a < 2; ++a)
#pragma unroll
            for (int b = 0; b < 2; ++b)
#pragma unroll
                for (int m = 0; m < 4; ++m)
#pragma unroll
                    for (int n = 0; n < 2; ++n) acc[a][b][m][n] = (f32x4){0.f, 0.f, 0.f, 0.f};
        cur = nxt; cA = nA; cB = nB; ++ui;
        if constexpr (ALIGN_EPI) { if (wr == 1) PG8_BAR; }
    }
    PG8_WAIT_V(0);
    if constexpr (!ALIGN_EPI) { if (wr == 0) PG8_BAR; }
    PG8_BAR;
#undef PG8_SA
#undef PG8_SB
#undef PG8_STAGE
#undef PG8_LDA
#undef PG8_LDB
#undef PG8_MMA
#undef PG8_WAIT_V
#undef PG8_WAIT_L
#undef PG8_BAR
#undef PG8_SCHED
}
}

#ifndef PG8_SP2
#define PG8_SP2 true
#endif
#ifndef PG8_ALIGN
#define PG8_ALIGN true
#endif

constexpr int NWAVES = 8, NTHREADS = NWAVES * 64;
constexpr int RING_BYTES = 131072, LDSCTL_OFF = RING_BYTES, LDS_BYTES = 147456;
constexpr int N_PHASES = 9;

__device__ __forceinline__ unsigned f2bf(float f) { unsigned u = __builtin_bit_cast(unsigned, f); return (u + 0x7fffu + ((u >> 16) & 1u)) >> 16; }
__device__ __forceinline__ unsigned pk2(float lo, float hi) { return f2bf(lo) | (f2bf(hi) << 16); }
__device__ __forceinline__ float bf2f(unsigned short b) { return __builtin_bit_cast(float, (unsigned)b << 16); }
__device__ __forceinline__ float wave_sum(float v) {
#pragma unroll
    for (int o = 1; o < 64; o <<= 1) v += __shfl_xor(v, o);
    return v;
}

#define XB_TMO      128
#define XB_XCNT(j)  (256  + 64 * (j))
#define XB_XSUB(j)  (1280 + 64 * (j))
#define XB_XGEN(j)  (2304 + 64 * (j))
#define XB_TOP      3328
#define XB_TOPGEN   3392
#define XCD_BAR_WORDS 3456
#define XB_SPIN_CAP (1u << 22)
__device__ __forceinline__ unsigned xb_ld(unsigned* p)              { return __hip_atomic_load(p, __ATOMIC_RELAXED, __HIP_MEMORY_SCOPE_AGENT); }
__device__ __forceinline__ unsigned xb_add(unsigned* p, unsigned v) { return __hip_atomic_fetch_add(p, v, __ATOMIC_RELAXED, __HIP_MEMORY_SCOPE_AGENT); }
__device__ __forceinline__ unsigned xb_xcc_id() { return (unsigned)__builtin_amdgcn_s_getreg((3 << 11) | 20) & 0xFu; }
#define XB_SPIN(cond, bar) do { unsigned _sp = 0; while (cond) { __builtin_amdgcn_s_sleep(1); \
    if ((++_sp & 255u) == 0u) { if (xb_ld(&(bar)[XB_TMO])) break; if (_sp > XB_SPIN_CAP) { atomicAdd(&(bar)[XB_TMO], 1u); break; } } } } while (0)
struct XcdBarrier { unsigned* bar; unsigned x; volatile LAS unsigned* st; };
__device__ __forceinline__ XcdBarrier xcd_barrier_post(unsigned* bar, volatile LAS unsigned* st) {
    XcdBarrier b; b.bar = bar; b.x = xb_xcc_id(); b.st = st;
    if (threadIdx.x == 0) (void)xb_add(&bar[XB_XCNT(b.x)], 1u);
    return b;
}
__device__ __forceinline__ void xcd_barrier_complete(unsigned* bar, unsigned x, unsigned& nloc, unsigned& nx) {
    const unsigned G = gridDim.x * gridDim.y * gridDim.z;
    unsigned sum, cnt, mine, sp = 0u;
    for (;;) {
        sum = 0u; cnt = 0u; mine = 0u;
#pragma unroll
        for (unsigned j = 0; j < 16; ++j) { const unsigned c = xb_ld(&bar[XB_XCNT(j)]); sum += c; cnt += (c > 0u) ? 1u : 0u; mine = (j == x) ? c : mine; }
        if (sum == G) break;
        __builtin_amdgcn_s_sleep(1);
        if ((++sp & 255u) == 0u) { if (xb_ld(&bar[XB_TMO])) break; if (sp > XB_SPIN_CAP) { atomicAdd(&bar[XB_TMO], 1u); break; } }
    }
    nloc = mine > 0u ? mine : 1u; nx = cnt > 0u ? cnt : 1u;
}
__device__ __forceinline__ void xcd_barrier(const XcdBarrier& b) {
    asm volatile("s_waitcnt vmcnt(0)" ::: "memory");
    __syncthreads();
    if (threadIdx.x == 0) {
        unsigned* bar = b.bar;
        __builtin_amdgcn_s_waitcnt(0);
        unsigned nloc = b.st[0], nx = b.st[1];
        if (nloc == 0u) { xcd_barrier_complete(bar, b.x, nloc, nx); b.st[0] = nloc; b.st[1] = nx; }
        const unsigned old = xb_add(&bar[XB_XSUB(b.x)], 1u);
        const unsigned gen = old / nloc;
        if (old + 1u == (gen + 1u) * nloc) {
            __builtin_amdgcn_fence(__ATOMIC_RELEASE, "agent");
            asm volatile("s_waitcnt vmcnt(0)" ::: "memory");
            const unsigned og = xb_add(&bar[XB_TOP], 1u);
            const unsigned tg = og / nx;
            if (og + 1u == (tg + 1u) * nx) xb_add(&bar[XB_TOPGEN], 1u);
            else XB_SPIN(xb_ld(&bar[XB_TOPGEN]) == tg, bar);
            __builtin_amdgcn_fence(__ATOMIC_ACQUIRE, "agent");
            xb_add(&bar[XB_XGEN(b.x)], 1u);
            asm volatile("s_waitcnt vmcnt(0)" ::: "memory");
        } else {
            XB_SPIN(xb_ld(&bar[XB_XGEN(b.x)]) == gen, bar);
            __builtin_amdgcn_fence(__ATOMIC_ACQUIRE, "agent");
            asm volatile("s_waitcnt vmcnt(0)" ::: "memory");
        }
    }
    __syncthreads();
}

struct Args {
    const float* in[25];
    float* out; unsigned char* ws;
    int ph_lo, ph_hi, use_cg, pad;
};
enum { I_XP = 0, I_XS, I_SC, I_SP, I_META, I_G1, I_W1G, I_W1U, I_W1D, I_GM, I_WIN, I_BIN, I_WDW, I_BDW, I_LNG, I_LNB, I_WPOOL, I_PSCALE, I_WOUT, I_BOUT, I_G2, I_W2G, I_W2U, I_W2D, I_GF };
constexpr size_t O_YP = 0, O_YS = (size_t)NB * SEQ * D, O_CP = O_YS + (size_t)MSA * D, O_PP = O_CP + (size_t)NB * CH * CC, O_CS = O_PP + (size_t)NB * PH * CPL, O_PS = O_CS + (size_t)NSB * CH * CC, O_END = O_PS + (size_t)NSB * PH * CPL;

__device__ __forceinline__ void transpose_item(const float* W, int K, int N, const float* gain, bf16_t* WT, int dest_row0, int k0, int n0, LAS float* scr, int lane) {
    float tv[32];
#pragma unroll
    for (int i = 0; i < 32; ++i) { const int kk = 2 * i + (lane >> 5); tv[i] = W[(size_t)(k0 + kk) * N + n0 + (lane & 31)]; }
#pragma unroll
    for (int i = 0; i < 32; ++i) { const int kk = 2 * i + (lane >> 5); float v = tv[i]; if (gain) v *= gain[k0 + kk]; scr[kk * 33 + (lane & 31)] = v; }
    asm volatile("s_waitcnt lgkmcnt(0)" ::: "memory");
    const int c = lane & 7;
#pragma unroll
    for (int j = 0; j < 4; ++j) { const int n = (lane >> 3) + 8 * j; const LAS float* s = scr + (8 * c) * 33 + n;
        u32x4 o; o.x = pk2(s[0 * 33], s[1 * 33]); o.y = pk2(s[2 * 33], s[3 * 33]); o.z = pk2(s[4 * 33], s[5 * 33]); o.w = pk2(s[6 * 33], s[7 * 33]);
        *(u32x4*)(WT + (size_t)(dest_row0 + n) * K + k0 + 8 * c) = o; }
    asm volatile("s_waitcnt lgkmcnt(0)" ::: "memory");
}

__device__ __forceinline__ const float* x0_row(const Args& a, int row) {
    if (row < MPR) { const int b = row / TP, t = row - b * TP; return t < NMETA ? a.in[I_META] + (size_t)t * D : a.in[I_XP] + ((size_t)b * SEQ + (t - NMETA)) * D; }
    return a.in[I_XS] + (size_t)(row - MPR) * D;
}

__device__ __forceinline__ void prep_phase(const Args& a, LAS unsigned char* lds, int gw, int NGW, int wave, int lane) {
    unsigned char* ws = a.ws;
    LAS float* scr = (LAS float*)(lds + wave * 16384);
    constexpr int I_FFN_GU = (D / 64) * (FF / 32);
    constexpr int I_FFN_D = (FF / 64) * (D / 32);
    constexpr int I_WIN_ = (D / 64) * (DIN / 32);
    constexpr int I_WOUT_ = (CC / 64) * (D / 32);
    constexpr int NITEMS = 6 * I_FFN_GU + I_WIN_ + I_WOUT_;
    static_assert(I_FFN_GU == I_FFN_D, "items");
    for (int it = gw; it < NITEMS; it += NGW) {
        int r = it;
        if (r < 6 * I_FFN_GU) {
            const int which = r / I_FFN_GU; r -= which * I_FFN_GU;
            const int ffn = which / 3, part = which % 3;
            if (part < 2) {
                const float* W = a.in[(ffn ? I_W2G : I_W1G) + part]; const float* gain = a.in[ffn ? I_G2 : I_G1];
                bf16_t* WT = (bf16_t*)(ws + (ffn ? WS_W2C : WS_W1C));
                const int nblk = FF / 32, kb = r / nblk, nb = r % nblk, n0 = nb * 32;
                const int dest = (n0 / 128) * 256 + part * 128 + (n0 % 128);
                transpose_item(W, D, FF, gain, WT, dest, kb * 64, n0, scr, lane);
            } else {
                const float* W = a.in[ffn ? I_W2D : I_W1D]; bf16_t* WT = (bf16_t*)(ws + (ffn ? WS_W2D : WS_W1D));
                const int nblk = D / 32, kb = r / nblk, nb = r % nblk;
                transpose_item(W, FF, D, nullptr, WT, nb * 32, kb * 64, nb * 32, scr, lane);
            }
            continue;
        }
        r -= 6 * I_FFN_GU;
        if (r < I_WIN_) {
            const int nblk = DIN / 32, kb = r / nblk, nb = r % nblk, n0 = nb * 32;
            int dest;
            if (n0 < CC) dest = (n0 / 128) * 256 + (n0 % 128);
            else if (n0 < 2 * CC) dest = ((n0 - CC) / 128) * 256 + 128 + (n0 % 128);
            else dest = n0;
            transpose_item(a.in[I_WIN], D, DIN, a.in[I_GM], (bf16_t*)(ws + WS_WIN), dest, kb * 64, n0, scr, lane);
            continue;
        }
        r -= I_WIN_;
        { const int nblk = D / 32, kb = r / nblk, nb = r % nblk;
          transpose_item(a.in[I_WOUT], D, D, nullptr, (bf16_t*)(ws + WS_WOUT), nb * 32, kb * 64, nb * 32, scr, lane); }
    }
    {
        const float* wp = a.in[I_WPOOL]; const float* ps = a.in[I_PSCALE]; const float* wo = a.in[I_WOUT]; bf16_t* WT = (bf16_t*)(ws + WS_WOUT);
        for (int it = gw; it < 1024; it += NGW) {
            const int g = it >> 8, cb = (it >> 4) & 15, nb = it & 15, n = nb * 64 + lane;
            float accv[8];
#pragma unroll
            for (int j = 0; j < 8; ++j) accv[j] = 0.f;
            for (int d0 = 0; d0 < PG; d0 += 16) {
                float wv[16];
#pragma unroll
                for (int dd = 0; dd < 16; ++dd) wv[dd] = wo[(size_t)(CC + g * PG + d0 + dd) * D + n];
#pragma unroll
                for (int dd = 0; dd < 16; ++dd) { const float x = wv[dd] * ps[g * PG + d0 + dd];
#pragma unroll
                    for (int j = 0; j < 8; ++j) accv[j] += wp[((size_t)g * PG + cb * 8 + j) * PG + d0 + dd] * x; }
            }
            *(u32x4*)(WT + (size_t)n * D + CC + g * PG + cb * 8) = (u32x4){pk2(accv[0], accv[1]), pk2(accv[2], accv[3]), pk2(accv[4], accv[5]), pk2(accv[6], accv[7])};
        }
    }
    {
        bf16_t* XB = (bf16_t*)(ws + WS_XB);
        for (int rp = gw; rp < MP / 2; rp += NGW) {
            f32x4 v[2][4];
#pragma unroll
            for (int h = 0; h < 2; ++h) {
                const int row = 2 * rp + h;
                if (row < M) { const f32x4* xr = (const f32x4*)x0_row(a, row) + lane;
#pragma unroll
                    for (int j = 0; j < 4; ++j) v[h][j] = xr[64 * j]; }
                else {
#pragma unroll
                    for (int j = 0; j < 4; ++j) v[h][j] = (f32x4){0.f, 0.f, 0.f, 0.f}; }
            }
#pragma unroll
            for (int h = 0; h < 2; ++h) {
                float s = 0.f;
#pragma unroll
                for (int j = 0; j < 4; ++j) s += (v[h][j].x * v[h][j].x + v[h][j].y * v[h][j].y) + (v[h][j].z * v[h][j].z + v[h][j].w * v[h][j].w);
                const float r = __builtin_amdgcn_rsqf(wave_sum(s) * (1.0f / D) + EPS);
                u32x2* bo = (u32x2*)(XB + (size_t)(2 * rp + h) * D) + lane;
#pragma unroll
                for (int j = 0; j < 4; ++j) bo[64 * j] = (u32x2){pk2(v[h][j].x * r, v[h][j].y * r), pk2(v[h][j].z * r, v[h][j].w * r)};
            }
        }
    }
}

typedef float f32x2 __attribute__((ext_vector_type(2)));
constexpr int N_PCH = 32;
constexpr int N_CHUNKS = NB * N_PCH + NSB;
__device__ __forceinline__ f32x2 unpk_bf2(unsigned u) { f32x2 r; r.x = __builtin_bit_cast(float, u << 16); r.y = __builtin_bit_cast(float, u & 0xffff0000u); return r; }
__device__ __forceinline__ void mixer_phase(const Args& a, LAS unsigned char* lds, int vcu, int G, int tid, int wave, int lane) {
    unsigned char* ws = a.ws;
    const bf16_t* UP = (const bf16_t*)(a.ws + WS_UP); bf16_t* A4 = (bf16_t*)(a.ws + WS_A4);
    LAS float* Cb = (LAS float*)lds;
    const bool convw = wave < 4;
    const int c2 = 2 * ((wave & 3) * 64 + lane);
    const int pgrp = wave & 3;
    f32x2 w[CW]; f32x2 bdw = (f32x2){0.f, 0.f};
    if (convw) {
#pragma unroll
        for (int k = 0; k < CW; ++k) w[k] = *(const f32x2*)(a.in[I_WDW] + k * CC + c2);
        bdw = *(const f32x2*)(a.in[I_BDW] + c2);
    } else {
#pragma unroll
        for (int k = 0; k < CW; ++k) w[k] = (f32x2){0.f, 0.f};
    }
    const float* lng = a.in[I_LNG]; const float* lnb = a.in[I_LNB];
    const int colofs = convw ? c2 : CC + c2;
    int buf = 0;
    for (int ch = vcu; ch < N_CHUNKS; ch += G) {
        const bool samp = ch >= NB * N_PCH;
        int rowbase, t0, nrows, pos0; const float* hist = nullptr;
        if (!samp) { const int b = ch >> 5, j = ch & 31; t0 = (j * TP) >> 5; nrows = (((j + 1) * TP) >> 5) - t0; rowbase = b * TP; pos0 = t0; }
        else { const int b = ch - NB * N_PCH; t0 = 0; nrows = TS; rowbase = MPR + b * TS; pos0 = PAST_LEN;
               hist = convw ? a.in[I_SC] + (size_t)b * CH * CC + c2 : a.in[I_SP] + (size_t)b * PH * CPL + c2; }
        const bf16_t* src = UP + (size_t)(rowbase + t0) * 1024 + colofs;
        f32x2 win[CH + 8];
        const int nh = convw ? CH : PH;
#pragma unroll
        for (int j = 0; j < CH; ++j) {
            f32x2 v = (f32x2){0.f, 0.f};
            const int hj = j - (CH - nh);
            if (hj >= 0) {
                if (samp) v = *(const f32x2*)(hist + hj * CC);
                else { const int t = t0 - nh + hj; if (t >= 0) v = unpk_bf2(*(const unsigned*)(src + (ptrdiff_t)(hj - nh) * 1024)); }
            }
            win[j] = v;
        }
        unsigned nx[8];
#pragma unroll
        for (int i = 0; i < 8; ++i) nx[i] = (i < nrows) ? *(const unsigned*)(src + (size_t)i * 1024) : 0u;
        const int ngrp = (nrows + 7) >> 3;
        for (int g = 0; g < ngrp; ++g) {
#pragma unroll
            for (int i = 0; i < 8; ++i) win[CH + i] = unpk_bf2(nx[i]);
            if (g + 1 < ngrp) {
#pragma unroll
                for (int i = 0; i < 8; ++i) { const int t = (g + 1) * 8 + i; nx[i] = (t < nrows) ? *(const unsigned*)(src + (size_t)t * 1024) : 0u; }
            }
            if (convw) {
                LAS float* cb = Cb + buf * (16 * CC) + ((g & 1) * 8) * CC + c2;
#pragma unroll
                for (int i = 0; i < 8; ++i) {
                    f32x2 o = bdw;
#pragma unroll
                    for (int k = 0; k < CW; ++k) o = w[k] * win[i + k] + o;
                    *(LAS f32x2*)(cb + i * CC) = o;
                }
            } else {
                const float wl = (float)(2 << pgrp);
#pragma unroll
                for (int i = 0; i < 8; ++i) {
                    const int q = CH + i;
                    const f32x2 s2 = win[q] + win[q - 1];
                    const f32x2 s4 = s2 + (win[q - 2] + win[q - 3]);
                    const f32x2 s8 = s4 + ((win[q - 4] + win[q - 5]) + (win[q - 6] + win[q - 7]));
                    const f32x2 s16 = s8 + (((win[q - 8] + win[q - 9]) + (win[q - 10] + win[q - 11])) + ((win[q - 12] + win[q - 13]) + (win[q - 14] + win[q - 15])));
                    const f32x2 ssel = pgrp == 0 ? s2 : (pgrp == 1 ? s4 : (pgrp == 2 ? s8 : s16));
                    const int t = g * 8 + i; const float posp1 = (float)(pos0 + t + 1);
                    const float inv = 1.0f / (posp1 < wl ? posp1 : wl);
                    const f32x2 dv = ssel * inv - win[q];
                    if (t < nrows) *(unsigned*)(A4 + (size_t)(rowbase + t0 + t) * 1024 + colofs) = pk2(dv.x, dv.y);
                }
            }
#pragma unroll
            for (int j = 0; j < CH; ++j) win[j] = win[j + 8];
            if ((g & 1) || g + 1 == ngrp) {
                __syncthreads();
                const int blk0 = (g >> 1) * 16;
#pragma unroll
                for (int h = 0; h < 2; ++h) {
                    const int lr = wave + 8 * h, t = blk0 + lr;
                    if (t < nrows) {
                        const LAS float* cr = Cb + buf * (16 * CC) + lr * CC + 8 * lane;
                        const f32x4 v0 = *(const LAS f32x4*)cr, v1 = *(const LAS f32x4*)(cr + 4);
                        const float mean = wave_sum(((v0.x + v0.y) + (v0.z + v0.w)) + ((v1.x + v1.y) + (v1.z + v1.w))) * (1.0f / CC);
                        const f32x4 d0 = v0 - mean, d1 = v1 - mean;
                        const float var = wave_sum(((d0.x * d0.x + d0.y * d0.y) + (d0.z * d0.z + d0.w * d0.w)) + ((d1.x * d1.x + d1.y * d1.y) + (d1.z * d1.z + d1.w * d1.w))) * (1.0f / CC);
                        const float rstd = __builtin_amdgcn_rsqf(var + EPS);
                        const f32x4 g0 = *(const f32x4*)(lng + 8 * lane), g1 = *(const f32x4*)(lng + 8 * lane + 4), b0 = *(const f32x4*)(lnb + 8 * lane), b1 = *(const f32x4*)(lnb + 8 * lane + 4);
                        f32x4 y0 = d0 * rstd * g0 + b0, y1 = d1 * rstd * g1 + b1;
#pragma unroll
                        for (int j = 0; j < 4; ++j) { y0[j] = y0[j] * pg8::sigmoidf_(y0[j]); y1[j] = y1[j] * pg8::sigmoidf_(y1[j]); }
                        *(u32x4*)(A4 + (size_t)(rowbase + t0 + t) * 1024 + 8 * lane) = (u32x4){pk2(y0.x, y0.y), pk2(y0.z, y0.w), pk2(y1.x, y1.y), pk2(y1.z, y1.w)};
                    }
                }
                buf ^= 1;
            }
        }
    }
    __syncthreads();
    for (int i = vcu * NTHREADS + tid; i < (MP - M) * 1024 / 8; i += G * NTHREADS) *(u32x4*)(A4 + (size_t)M * 1024 + (size_t)i * 8) = (u32x4){0u, 0u, 0u, 0u};
    {
        float* out = a.out;
        const int gt = vcu * NTHREADS + tid, GT = G * NTHREADS;
        for (int i = gt; i < NB * CH * CC; i += GT) { const int cch = i % CC, j = (i / CC) % CH, b = i / (CC * CH); out[O_CP + i] = bf2f(UP[(size_t)(b * TP + TP - CH + j) * 1024 + cch]); }
        for (int i = gt; i < NB * PH * CPL; i += GT) { const int cch = i % CPL, j = (i / CPL) % PH, b = i / (CPL * PH); out[O_PP + i] = bf2f(UP[(size_t)(b * TP + TP - PH + j) * 1024 + CC + cch]); }
        for (int i = gt; i < NSB * CH * CC; i += GT) { const int cch = i % CC, j = (i / CC) % CH, b = i / (CC * CH);
            out[O_CS + i] = (j < CH - TS) ? a.in[I_SC][((size_t)b * CH + j + TS) * CC + cch] : bf2f(UP[(size_t)(MPR + b * TS + (j - (CH - TS))) * 1024 + cch]); }
        for (int i = gt; i < NSB * PH * CPL; i += GT) { const int cch = i % CPL, j = (i / CPL) % PH, b = i / (CPL * PH);
            out[O_PS + i] = (j < PH - TS) ? a.in[I_SP][((size_t)b * PH + j + TS) * CPL + cch] : bf2f(UP[(size_t)(MPR + b * TS + (j - (PH - TS))) * 1024 + CC + cch]); }
    }
}


__device__ __forceinline__ void final_phase(const Args& a, int gw, int NGW, int lane) {
    const float* X = (const float*)(a.ws + WS_X); const float* ssq = (const float*)(a.ws + WS_SSQ3); const float* gf = a.in[I_GF];
    f32x4 gv[4];
#pragma unroll
    for (int j = 0; j < 4; ++j) gv[j] = *((const f32x4*)gf + lane + 64 * j);
    constexpr int NOUT = NB * SEQ + MSA;
    for (int o = gw; o < NOUT; o += NGW) {
        int row; float* dst;
        if (o < NB * SEQ) { const int b = o / SEQ, t = o - b * SEQ; row = b * TP + NMETA + t; dst = a.out + O_YP + (size_t)o * D; }
        else { row = MPR + (o - NB * SEQ); dst = a.out + O_YS + (size_t)(o - NB * SEQ) * D; }
        const f32x4* sp = (const f32x4*)(ssq + (size_t)row * 16);
        const f32x4 p0 = sp[0], p1 = sp[1], p2 = sp[2], p3 = sp[3];
        const float s = (((p0.x + p0.y) + (p0.z + p0.w)) + ((p1.x + p1.y) + (p1.z + p1.w))) + (((p2.x + p2.y) + (p2.z + p2.w)) + ((p3.x + p3.y) + (p3.z + p3.w)));
        const float r = __builtin_amdgcn_rsqf(s * (1.0f / D) + EPS);
        const f32x4* xr = (const f32x4*)(X + (size_t)row * D) + lane; f32x4* yo = (f32x4*)dst + lane;
#pragma unroll
        for (int j = 0; j < 4; ++j) yo[64 * j] = xr[64 * j] * r * gv[j];
    }
}

__global__ void __launch_bounds__(NTHREADS, 2) mk_fwd(Args args) {
    extern __shared__ __attribute__((aligned(16))) unsigned char lds_raw[];
    LAS unsigned char* lds = (LAS unsigned char*)lds_raw;
    volatile LAS unsigned* MISC = (volatile LAS unsigned*)(lds + LDSCTL_OFF);
    const int tid = threadIdx.x, lane = tid & 63, wave = __builtin_amdgcn_readfirstlane(tid >> 6);
    const int G = gridDim.x; const int bx = blockIdx.x; const int vcu = (G % 8 == 0) ? (bx % 8) * (G / 8) + bx / 8 : bx;
    const int gw = vcu * NWAVES + wave, NGW = G * NWAVES;
    unsigned char* ws = args.ws;
    if (tid < 64) MISC[tid] = 0u;
    __syncthreads();
    XcdBarrier bar; bar.bar = (unsigned*)(ws + WS_CTL) + 1024; bar.x = 0; bar.st = nullptr;
    if (MK_N_LAUNCHES == 1) bar = xcd_barrier_post((unsigned*)(ws + WS_CTL) + 1024, MISC + 8);
    const int lo = args.ph_lo, hi = args.ph_hi;
#define IN(k) (lo <= (k) && (k) < hi)
#define BOTH(k) (IN(k) && IN((k) + 1))
#define GRID_BAR() do { if (args.use_cg) { cg::this_grid().sync(); } else { xcd_barrier(bar); } } while (0)

    bf16_t* XB = (bf16_t*)(ws + WS_XB); float* X = (float*)(ws + WS_X); bf16_t* R1 = (bf16_t*)(ws + WS_R1);
    float* SSQ1 = (float*)(ws + WS_SSQ1); float* SSQ2 = (float*)(ws + WS_SSQ2); float* SSQ3 = (float*)(ws + WS_SSQ3);

#ifndef PROBE_DUP
#define PROBE_DUP -1
#endif
    if (IN(0)) { prep_phase(args, lds, gw, NGW, wave, lane); if (PROBE_DUP == 0) { __syncthreads(); prep_phase(args, lds, gw, NGW, wave, lane); } if (BOTH(0)) { cg::this_grid().sync(); } }

    if (IN(1)) {
        pg8::Gemm g{XB, (const bf16_t*)(ws + WS_W1C), MP, 2 * FF, D}; pg8::StaticOrder S; S.init(MP, 2 * FF, G, bx);
        pg8::EpiSwiglu<false> E{R1, nullptr};
        pg8::gemm_phase<pg8::EpiSwiglu<false>, pg8::StaticOrder, PG8_ALIGN, PG8_SP2>(lds, g, S, E);
        if (BOTH(1)) GRID_BAR();
    }
    if (IN(2)) {
        pg8::Gemm g{R1, (const bf16_t*)(ws + WS_W1D), MP, D, FF}; pg8::StaticOrder S; S.init(MP, D, G, bx);
        pg8::EpiResid<false, true, true> E{X, XB, SSQ1, nullptr, 0.5f, args.in[I_XP], args.in[I_XS], args.in[I_META]};
        pg8::gemm_phase<pg8::EpiResid<false, true, true>, pg8::StaticOrder, PG8_ALIGN, PG8_SP2>(lds, g, S, E);
        if (BOTH(2)) GRID_BAR();
    }
    if (IN(3)) {
        pg8::Gemm g{XB, (const bf16_t*)(ws + WS_WIN), MP, DIN, D}; pg8::StaticOrder S; S.init(MP, DIN, G, bx);
        pg8::EpiWin E{(bf16_t*)(ws + WS_UP), SSQ1, args.in[I_BIN]};
        pg8::gemm_phase<pg8::EpiWin, pg8::StaticOrder, PG8_ALIGN, PG8_SP2>(lds, g, S, E);
        if (BOTH(3)) GRID_BAR();
    }
    if (IN(4)) { mixer_phase(args, lds, vcu, G, tid, wave, lane); if (PROBE_DUP == 4) { __syncthreads(); mixer_phase(args, lds, vcu, G, tid, wave, lane); } if (BOTH(4)) GRID_BAR(); }
    if (IN(5)) {
        pg8::Gemm g{(const bf16_t*)(ws + WS_A4), (const bf16_t*)(ws + WS_WOUT), MP, D, D}; pg8::StaticOrder S; S.init(MP, D, G, bx);
        pg8::EpiResid<true, true> E{X, XB, SSQ2, args.in[I_BOUT], 1.0f, nullptr, nullptr, nullptr};
        pg8::gemm_phase<pg8::EpiResid<true, true>, pg8::StaticOrder, PG8_ALIGN, PG8_SP2>(lds, g, S, E);
        if (BOTH(5)) GRID_BAR();
    }
    if (IN(6)) {
        pg8::Gemm g{XB, (const bf16_t*)(ws + WS_W2C), MP, 2 * FF, D}; pg8::StaticOrder S; S.init(MP, 2 * FF, G, bx);
        pg8::EpiSwiglu<true> E{R1, SSQ2};
        pg8::gemm_phase<pg8::EpiSwiglu<true>, pg8::StaticOrder, PG8_ALIGN, PG8_SP2>(lds, g, S, E);
        if (BOTH(6)) GRID_BAR();
    }
    if (IN(7)) {
        pg8::Gemm g{R1, (const bf16_t*)(ws + WS_W2D), MP, D, FF}; pg8::StaticOrder S; S.init(MP, D, G, bx);
        pg8::EpiResid<false, false> E{X, nullptr, SSQ3, nullptr, 0.5f, nullptr, nullptr, nullptr};
        pg8::gemm_phase<pg8::EpiResid<false, false>, pg8::StaticOrder, PG8_ALIGN, PG8_SP2>(lds, g, S, E);
        if (BOTH(7)) GRID_BAR();
    }
    if (IN(8)) { final_phase(args, gw, NGW, lane); if (PROBE_DUP == 8) final_phase(args, gw, NGW, lane); }
#undef IN
#undef BOTH
#undef GRID_BAR
}

extern "C" void kernel_launch(void* const* d_in, const int* in_sizes, int n_in, void* d_out, int out_size, void* d_ws, size_t ws_size, hipStream_t stream) {
    static int grid = 0;
    if (grid == 0) {
        if (n_in != 25 || (size_t)out_size != O_END || ws_size < WS_END) { fprintf(stderr, "kernel_launch: unexpected shapes (n_in %d out %d ws %zu)\n", n_in, out_size, ws_size); grid = -1; return; }
        int dev = 0, cus = 0, per_cu = 0;
        if (hipGetDevice(&dev) != hipSuccess || hipDeviceGetAttribute(&cus, hipDeviceAttributeMultiprocessorCount, dev) != hipSuccess) { grid = -1; return; }
        if (hipFuncSetAttribute((const void*)mk_fwd, hipFuncAttributeMaxDynamicSharedMemorySize, LDS_BYTES) != hipSuccess) { fprintf(stderr, "kernel_launch: hipFuncSetAttribute failed\n"); grid = -1; return; }
        if (hipOccupancyMaxActiveBlocksPerMultiprocessor(&per_cu, (const void*)mk_fwd, NTHREADS, LDS_BYTES) != hipSuccess || per_cu < 1) { fprintf(stderr, "kernel_launch: occupancy query says %d\n", per_cu); per_cu = 1; }
        (void)hipGetLastError();
        grid = cus * 1;
    }
    if (grid < 0) return;
    (void)hipMemsetAsync((char*)d_ws + WS_CTL, 0, CTL_ZERO_BYTES, stream);
    Args a{};
    for (int i = 0; i < 25; ++i) a.in[i] = (const float*)d_in[i];
    a.out = (float*)d_out; a.ws = (unsigned char*)d_ws;
    if (MK_N_LAUNCHES == 1) {
        a.ph_lo = 0; a.ph_hi = N_PHASES; a.use_cg = 0;
        void* kargs[] = {&a};
        hipError_t e = hipLaunchCooperativeKernel((const void*)mk_fwd, dim3(grid), dim3(NTHREADS), kargs, LDS_BYTES, stream);
        if (e != hipSuccess) fprintf(stderr, "kernel_launch: cooperative launch failed: %s (grid %d)\n", hipGetErrorString(e), grid);
    } else {
        for (int p = 0; p < N_PHASES; ++p) {
            a.ph_lo = p; a.ph_hi = p + 1; a.use_cg = 0;
            hipLaunchKernelGGL(mk_fwd, dim3(grid), dim3(NTHREADS), LDS_BYTES, stream, a);
        }
    }
}
```
